# Optimizing an MI355X kernel written in HIP

```python
import math
import jax, jax.numpy as jnp
from jax import lax
import numpy as np

D_MODEL = 4096
BATCH = 2
SEQ = 8192
DEPTH = 1

MIX_WIDTH = D_MODEL
ATT_WIDTH = MIX_WIDTH // 2
RET_WIDTH = MIX_WIDTH - ATT_WIDTH
N_ATT_HEADS = 8
ATT_VDIM = ATT_WIDTH // N_ATT_HEADS
ATT_QKDIM = ATT_VDIM // 2
N_RET_HEADS = 8
RET_VDIM = RET_WIDTH // N_RET_HEADS
RET_QKDIM = RET_VDIM // 2
D_FF = 4 * D_MODEL
ATT_Q = N_ATT_HEADS * 2 * ATT_QKDIM
ATT_K = N_ATT_HEADS * 2 * ATT_QKDIM
ATT_V = ATT_WIDTH
RET_Q = N_RET_HEADS * RET_QKDIM
RET_K = N_RET_HEADS * RET_QKDIM
RET_V = RET_WIDTH
RET_G = RET_WIDTH
IN_COLS = ATT_Q + ATT_K + ATT_V + RET_Q + RET_K + RET_V + RET_G
N_BUCKETS = 32
MAX_DISTANCE = 128
Q_BLOCK = 128
RET_CHUNK = 128
ROT_BASE = 10000.0
NORM_EPS = 1e-5
NEG_INF = -1e30
DEEPNORM_ALPHA = (2 * DEPTH) ** 0.25
DEEPNORM_BETA = (8 * DEPTH) ** -0.25

kernel_name = "hybrid_diffattn_retention_deepnorm"


def layer_norm(x, g, b):
    xf = x.astype(jnp.float32)
    mu = jnp.mean(xf, axis=-1, keepdims=True)
    xc = xf - mu
    var = jnp.mean(jnp.square(xc), axis=-1, keepdims=True)
    y = xc * lax.rsqrt(var + NORM_EPS)
    return (y * g.astype(jnp.float32) + b.astype(jnp.float32)).astype(x.dtype)


def t5_bucket(rel):
    n = jnp.maximum(-rel, 0)
    max_exact = N_BUCKETS // 2
    nf = jnp.maximum(n, 1).astype(jnp.float32)
    large = max_exact + (jnp.log(nf / max_exact) / math.log(MAX_DISTANCE / max_exact)
                         * (N_BUCKETS - max_exact)).astype(jnp.int32)
    large = jnp.minimum(large, N_BUCKETS - 1)
    return jnp.where(n < max_exact, n, large)


def diff_attention(q, k, v, lam_p, subln_g, rel_bias, lambda_init):
    B, S, H, _, dq = q.shape
    dv = v.shape[-1]
    scale = dq ** -0.5
    lp = lam_p.astype(jnp.float32)
    lam = jnp.exp(jnp.sum(lp[0] * lp[1])) - jnp.exp(jnp.sum(lp[2] * lp[3])) + lambda_init
    nb = S // Q_BLOCK
    q_blocks = q.reshape(B, nb, Q_BLOCK, H, 2, dq).transpose(1, 0, 2, 3, 4, 5)
    k_pos = jnp.arange(S)
    v32 = v.astype(jnp.float32)
    bias_tab = rel_bias.astype(jnp.float32)

    def block(args):
        q_blk, i = args
        q_pos = i * Q_BLOCK + jnp.arange(Q_BLOCK)
        rel = k_pos[None, :] - q_pos[:, None]
        bias = bias_tab[t5_bucket(rel)].transpose(2, 0, 1)
        s = jnp.einsum('bqhmd,bkhmd->bhmqk', q_blk, k).astype(jnp.float32) * scale
        s = s + bias[None, :, None]
        s = jnp.where((rel <= 0)[None, None, None], s, NEG_INF)
        p = jax.nn.softmax(s, axis=-1)
        a = p[:, :, 0] - lam * p[:, :, 1]
        return jnp.einsum('bhqk,bkhe->bqhe', a, v32)

    o = lax.map(block, (q_blocks, jnp.arange(nb)))
    o = o.transpose(1, 0, 2, 3, 4).reshape(B, S, H, dv)
    o = o * lax.rsqrt(jnp.mean(jnp.square(o), axis=-1, keepdims=True) + NORM_EPS)
    o = o * subln_g.astype(jnp.float32) * (1.0 - lambda_init)
    return o.reshape(B, S, H * dv).astype(v.dtype)


def rotate(x, cos, sin):
    half = x.shape[-1] // 2
    x1, x2 = x[..., :half], x[..., half:]
    return jnp.concatenate([x1 * cos - x2 * sin, x2 * cos + x1 * sin], axis=-1)


def retention(q, k, v, g, gn_g):
    B, S, H, dk = q.shape
    dv = v.shape[-1]
    out_dtype = v.dtype
    q = q.astype(jnp.float32)
    k = k.astype(jnp.float32)
    v = v.astype(jnp.float32)
    pos = jnp.arange(S, dtype=jnp.float32)
    inv_freq = 1.0 / (ROT_BASE ** jnp.linspace(0.0, 1.0, dk // 2, dtype=jnp.float32))
    ang = pos[:, None] * inv_freq[None, :]
    cos = jnp.cos(ang)[:, None, :]
    sin = jnp.sin(ang)[:, None, :]
    q = rotate(q, cos, sin)
    k = rotate(k, cos, sin) * dk ** -0.5
    log_gamma = jnp.log1p(-jnp.exp2(-5.0 - jnp.arange(H, dtype=jnp.float32)))
    C = RET_CHUNK
    n = S // C
    idx = jnp.arange(C, dtype=jnp.float32)
    diff = idx[:, None] - idx[None, :]
    intra_decay = jnp.where(diff[None] >= 0,
                            jnp.exp(jnp.maximum(diff, 0.0)[None] * log_gamma[:, None, None]), 0.0)
    cross_decay = jnp.exp((idx + 1.0)[None, :] * log_gamma[:, None])[..., None]
    key_decay = jnp.exp((C - 1.0 - idx)[None, :] * log_gamma[:, None])[..., None]
    chunk_decay = jnp.exp(C * log_gamma)[:, None, None]

    def to_chunks(t):
        return t.reshape(B, n, C, H, t.shape[-1]).transpose(1, 0, 3, 2, 4)

    def step(R, inp):
        qc, kc, vc = inp
        inner = jnp.einsum('bhcm,bhme->bhce', jnp.einsum('bhcd,bhmd->bhcm', qc, kc) * intra_decay, vc)
        cross = jnp.einsum('bhcd,bhde->bhce', qc, R) * cross_decay
        R = R * chunk_decay + jnp.einsum('bhmd,bhme->bhde', kc * key_decay, vc)
        return R, inner + cross

    R0 = jnp.zeros((B, H, dk, dv), jnp.float32)
    _, o = lax.scan(step, R0, (to_chunks(q), to_chunks(k), to_chunks(v)))
    o = o.transpose(1, 0, 3, 2, 4).reshape(B, S, H, dv)
    mu = jnp.mean(o, axis=-1, keepdims=True)
    oc = o - mu
    o = oc * lax.rsqrt(jnp.mean(jnp.square(oc), axis=-1, keepdims=True) + NORM_EPS)
    o = o.reshape(B, S, H * dv) * gn_g.astype(jnp.float32)
    return (jax.nn.silu(g.astype(jnp.float32)) * o).astype(out_dtype)


def setup_inputs(seed: int = 0) -> dict:
    key = jax.random.key(seed)
    ks = jax.random.split(key, 14)
    f32 = jnp.float32
    beta = DEEPNORM_BETA
    col_scale = np.concatenate([
        np.ones(ATT_Q + ATT_K), np.full(ATT_V, beta),
        np.ones(RET_Q + RET_K), np.full(RET_V, beta), np.ones(RET_G)]).astype(np.float32)
    x = jax.random.normal(ks[0], (BATCH, SEQ, D_MODEL), f32)
    w_in = jax.random.normal(ks[1], (DEPTH, D_MODEL, IN_COLS), f32) * (D_MODEL ** -0.5) * jnp.asarray(col_scale)
    att_lambda = jax.random.normal(ks[2], (DEPTH, 4, ATT_QKDIM), f32) * 0.1
    att_subln_g = 1.0 + 0.02 * jax.random.normal(ks[3], (DEPTH, ATT_VDIM), f32)
    ret_gn_g = 1.0 + 0.02 * jax.random.normal(ks[4], (DEPTH, RET_WIDTH), f32)
    w_out = jax.random.normal(ks[5], (DEPTH, MIX_WIDTH, D_MODEL), f32) * (MIX_WIDTH ** -0.5) * beta
    ln1_g = 1.0 + 0.02 * jax.random.normal(ks[6], (DEPTH, D_MODEL), f32)
    ln1_b = 0.02 * jax.random.normal(ks[7], (DEPTH, D_MODEL), f32)
    w_ff1 = jax.random.normal(ks[8], (DEPTH, D_MODEL, D_FF), f32) * (D_MODEL ** -0.5) * beta
    w_ff2 = jax.random.normal(ks[9], (DEPTH, D_FF, D_MODEL), f32) * (D_FF ** -0.5) * beta
    ln2_g = 1.0 + 0.02 * jax.random.normal(ks[10], (DEPTH, D_MODEL), f32)
    ln2_b = 0.02 * jax.random.normal(ks[11], (DEPTH, D_MODEL), f32)
    rel_bias = 0.5 * jax.random.normal(ks[12], (N_BUCKETS, N_ATT_HEADS), f32)
    return {"x": x, "w_in": w_in, "att_lambda": att_lambda, "att_subln_g": att_subln_g,
            "ret_gn_g": ret_gn_g, "w_out": w_out, "ln1_g": ln1_g, "ln1_b": ln1_b,
            "w_ff1": w_ff1, "w_ff2": w_ff2, "ln2_g": ln2_g, "ln2_b": ln2_b,
            "rel_bias": rel_bias}


def reference(x, w_in, att_lambda, att_subln_g, ret_gn_g, w_out, ln1_g, ln1_b,
              w_ff1, w_ff2, ln2_g, ln2_b, rel_bias):
    B, S, _ = x.shape
    bounds = [ATT_Q, ATT_Q + ATT_K, ATT_Q + ATT_K + ATT_V,
              ATT_Q + ATT_K + ATT_V + RET_Q,
              ATT_Q + ATT_K + ATT_V + RET_Q + RET_K,
              ATT_Q + ATT_K + ATT_V + RET_Q + RET_K + RET_V]
    for layer in range(DEPTH):
        lambda_init = 0.8 - 0.6 * math.exp(-0.3 * (layer + 1))
        proj = x @ w_in[layer]
        qa, ka, va, qr, kr, vr, gr = jnp.split(proj, bounds, axis=-1)
        att = diff_attention(qa.reshape(B, S, N_ATT_HEADS, 2, ATT_QKDIM),
                             ka.reshape(B, S, N_ATT_HEADS, 2, ATT_QKDIM),
                             va.reshape(B, S, N_ATT_HEADS, ATT_VDIM),
                             att_lambda[layer], att_subln_g[layer], rel_bias, lambda_init)
        ret = retention(qr.reshape(B, S, N_RET_HEADS, RET_QKDIM),
                        kr.reshape(B, S, N_RET_HEADS, RET_QKDIM),
                        vr.reshape(B, S, N_RET_HEADS, RET_VDIM),
                        gr, ret_gn_g[layer])
        mix = jnp.concatenate([att, ret], axis=-1) @ w_out[layer]
        x = layer_norm(DEEPNORM_ALPHA * x + mix, ln1_g[layer], ln1_b[layer])
        ff = jnp.square(jax.nn.relu(x @ w_ff1[layer])) @ w_ff2[layer]
        x = layer_norm(DEEPNORM_ALPHA * x + ff, ln2_g[layer], ln2_b[layer])
    return x
```

```cpp
#include <hip/hip_runtime.h>
#include <cstdio>
#include <cstdint>
#include <cmath>
namespace pg8 {
#define PG8_LAS __attribute__((address_space(3)))
typedef unsigned short bf16_t;
typedef short bf16x8 __attribute__((ext_vector_type(8)));
typedef float f32x4 __attribute__((ext_vector_type(4)));
typedef unsigned u32x4 __attribute__((ext_vector_type(4)));
constexpr int BM = 256, BK = 64, HALF = 128, HTB = HALF * BK * 2  , STAGE_BYTES = 8 * HTB, NXCD = 8, WGM = 8;

__host__ __device__ __forceinline__ int lds_byte(int r, int c) { const int st = (r >> 4) * 2 + (c >> 5), rr = r & 15, cc = c & 31, ob = rr * 64 + cc * 2; return st * 1024 + (ob ^ (((ob >> 9) & 1) << 5)); }
__host__ __device__ __forceinline__ void stage_rc(int b, int& R, int& C) { const int st = b / 1024, sb = b % 1024, swz = sb ^ (((sb >> 9) & 1) << 5); R = (st >> 1) * 16 + swz / 64; C = (st & 1) * 32 + (swz % 64) / 2; }
__host__ __device__ __forceinline__ int perm32(int rho) { const int n = rho >> 4, i = rho & 15; return 8 * (i >> 2) + 4 * n + (i & 3); }

struct Unit { int pm, pn; };
struct Gemm { const bf16_t* A; const bf16_t* Bt; int M, N, K; };

struct StaticOrder {
    int nM, nN, nwg, G, c;
    __host__ __device__ void init(int M, int N, int G_, int c_) { nM = M / BM; nN = N / BM; nwg = nM * nN; G = G_; c = c_; }
    __host__ __device__ bool next(int i, Unit& u) const {
        const long L = (long)i * G + c; if (L >= nwg) return false;
        int wgid = (int)L; { const int q = nwg / NXCD, r = nwg % NXCD, xcd = wgid % NXCD, off = wgid / NXCD; wgid = (xcd < r ? xcd * (q + 1) : r * (q + 1) + (xcd - r) * q) + off; }
        const int nig = WGM * nN, gid = wgid / nig, fm = gid * WGM, gsz = (nM - fm) < WGM ? (nM - fm) : WGM;
        u.pm = fm + ((wgid % nig) % gsz); u.pn = (wgid % nig) / gsz; return true;
    }
    __device__ __forceinline__ void a_ready(const Unit&) const {}
    __device__ __forceinline__ void done(const Unit&) const {}
};

struct RangeOrder {
    StaticOrder S; int i0, n;
    __host__ __device__ bool next(int i, Unit& u) const { return i < n && S.next(i + i0, u); }
    __device__ __forceinline__ void a_ready(const Unit&) const {}
    __device__ __forceinline__ void done(const Unit&) const {}
};

__device__ __forceinline__ unsigned cvt_pk_bf16(float lo, float hi) { unsigned r; asm volatile("v_cvt_pk_bf16_f32 %0, %1, %2" : "=v"(r) : "v"(lo), "v"(hi)); return r; }
typedef float f32x2 __attribute__((ext_vector_type(2)));
constexpr int NPROJ = 12288;
constexpr float QSCALE = 0.08838834764831845f * 1.4426950408889634f;
struct EpiProj {
    static constexpr bool PERM = true, AFTER_DRAIN = false;
    bf16_t* O; const float* rope; const float* dec;
    __device__ __forceinline__ void operator()(const f32x4 (&acc)[2][2][4][2], const Unit& u, int wr, int wc, int fr, int fq) const {
        const int row0 = u.pm * BM + wr * 64 + fr, col0 = u.pn * BM + wc * 32 + 8 * fq, pn = u.pn;
        if (pn >= 24 && pn < 32) {
            const int isk = pn >= 28 ? 1 : 0, hb = 2 * (pn - (isk ? 28 : 24)), i0 = 16 * wc + 4 * fq;
#pragma unroll
            for (int ai = 0; ai < 2; ++ai)
#pragma unroll
                for (int m = 0; m < 4; ++m) {
                    const int row = row0 + ai * HALF + m * 16, pos = row & 8191, cc = pos & 127;
                    const f32x4 cs0 = *(const f32x4*)(rope + ((size_t)pos * 64 + i0) * 2), cs1 = *(const f32x4*)(rope + ((size_t)pos * 64 + i0) * 2 + 4);
                    bf16_t* rowp = O + (size_t)row * NPROJ + col0;
#pragma unroll
                    for (int bj = 0; bj < 2; ++bj) {
                        const float d = dec[((hb + bj) * 128 + cc) * 2 + isk];
                        const f32x4 v0 = acc[ai][bj][m][0], v1 = acc[ai][bj][m][1];
                        const float a0 = (v0[0] * cs0[0] - v0[1] * cs0[1]) * d, a1 = (v0[1] * cs0[0] + v0[0] * cs0[1]) * d;
                        const float a2 = (v0[2] * cs0[2] - v0[3] * cs0[3]) * d, a3 = (v0[3] * cs0[2] + v0[2] * cs0[3]) * d;
                        const float a4 = (v1[0] * cs1[0] - v1[1] * cs1[1]) * d, a5 = (v1[1] * cs1[0] + v1[0] * cs1[1]) * d;
                        const float a6 = (v1[2] * cs1[2] - v1[3] * cs1[3]) * d, a7 = (v1[3] * cs1[2] + v1[2] * cs1[3]) * d;
                        u32x4 w; w.x = cvt_pk_bf16(a0, a1); w.y = cvt_pk_bf16(a2, a3); w.z = cvt_pk_bf16(a4, a5); w.w = cvt_pk_bf16(a6, a7);
                        *(u32x4*)(rowp + bj * HALF) = w;
                    }
                }
        } else {
            const float sc = pn < 8 ? QSCALE : 1.0f;
#pragma unroll
            for (int ai = 0; ai < 2; ++ai)
#pragma unroll
                for (int m = 0; m < 4; ++m) { bf16_t* rowp = O + (size_t)(row0 + ai * HALF + m * 16) * NPROJ + col0;
#pragma unroll
                    for (int bj = 0; bj < 2; ++bj) { const f32x4 v0 = acc[ai][bj][m][0] * sc, v1 = acc[ai][bj][m][1] * sc;
                        u32x4 w; w.x = cvt_pk_bf16(v0[0], v0[1]); w.y = cvt_pk_bf16(v0[2], v0[3]); w.z = cvt_pk_bf16(v1[0], v1[1]); w.w = cvt_pk_bf16(v1[2], v1[3]);
                        *(u32x4*)(rowp + bj * HALF) = w; } }
        }
    }
};
struct EpiPre1 {
    static constexpr bool PERM = true, AFTER_DRAIN = false;
    const float* xin; bf16_t* O; float* stats; int ldc; float alpha;
    __device__ __forceinline__ void operator()(const f32x4 (&acc)[2][2][4][2], const Unit& u, int wr, int wc, int fr, int fq) const {
        const int row0 = u.pm * BM + wr * 64 + fr, col0 = u.pn * BM + wc * 32 + 8 * fq;
#pragma unroll
        for (int ai = 0; ai < 2; ++ai) {
            f32x4 b[4][2][2];
#pragma unroll
            for (int m = 0; m < 4; ++m) { const size_t off = (size_t)(row0 + ai * HALF + m * 16) * ldc + col0;
#pragma unroll
                for (int bj = 0; bj < 2; ++bj) { b[m][bj][0] = *(const f32x4*)(xin + off + bj * HALF); b[m][bj][1] = *(const f32x4*)(xin + off + bj * HALF + 4); } }
#pragma unroll
            for (int m = 0; m < 4; ++m) { const int row = row0 + ai * HALF + m * 16; const size_t off = (size_t)row * ldc + col0;
                float s1 = 0.f, s2 = 0.f;
#pragma unroll
                for (int bj = 0; bj < 2; ++bj) { const f32x4 v0 = b[m][bj][0] * alpha + acc[ai][bj][m][0], v1 = b[m][bj][1] * alpha + acc[ai][bj][m][1];
                    s1 += ((v0[0] + v0[1]) + (v0[2] + v0[3])) + ((v1[0] + v1[1]) + (v1[2] + v1[3]));
                    s2 += ((v0[0] * v0[0] + v0[1] * v0[1]) + (v0[2] * v0[2] + v0[3] * v0[3])) + ((v1[0] * v1[0] + v1[1] * v1[1]) + (v1[2] * v1[2] + v1[3] * v1[3]));
                    u32x4 w; w.x = cvt_pk_bf16(v0[0], v0[1]); w.y = cvt_pk_bf16(v0[2], v0[3]); w.z = cvt_pk_bf16(v1[0], v1[1]); w.w = cvt_pk_bf16(v1[2], v1[3]);
                    *(u32x4*)(O + off + bj * HALF) = w; }
                s1 += __shfl_xor(s1, 16); s2 += __shfl_xor(s2, 16); s1 += __shfl_xor(s1, 32); s2 += __shfl_xor(s2, 32);
                if (fq == 0) { unsafeAtomicAdd(stats + 2 * row, s1); unsafeAtomicAdd(stats + 2 * row + 1, s2); } }
            asm volatile("" ::: "memory");
        }
    }
};
struct EpiSqReluLn {
    static constexpr bool PERM = true, AFTER_DRAIN = false;
    bf16_t* O; int ldc; const float* stats; const float* uvec; const float* cvec; float inv_n, eps;
    __device__ __forceinline__ void operator()(const f32x4 (&acc)[2][2][4][2], const Unit& u, int wr, int wc, int fr, int fq) const {
        const int row0 = u.pm * BM + wr * 64 + fr, col0 = u.pn * BM + wc * 32 + 8 * fq;
        f32x4 uv[2][2], cv[2][2];
#pragma unroll
        for (int bj = 0; bj < 2; ++bj)
#pragma unroll
            for (int n = 0; n < 2; ++n) { uv[bj][n] = *(const f32x4*)(uvec + col0 + bj * HALF + 4 * n); cv[bj][n] = *(const f32x4*)(cvec + col0 + bj * HALF + 4 * n); }
        f32x2 st[2][4];
#pragma unroll
        for (int ai = 0; ai < 2; ++ai)
#pragma unroll
            for (int m = 0; m < 4; ++m) st[ai][m] = *(const f32x2*)(stats + 2 * (row0 + ai * HALF + m * 16));
#pragma unroll
        for (int ai = 0; ai < 2; ++ai)
#pragma unroll
            for (int m = 0; m < 4; ++m) { const int row = row0 + ai * HALF + m * 16; bf16_t* rowp = O + (size_t)row * ldc + col0;
                const float s1 = st[ai][m][0], s2 = st[ai][m][1];
                const float mu = s1 * inv_n, var = fmaxf(s2 * inv_n - mu * mu, 0.f), r = 1.0f / sqrtf(var + eps), mr = -mu * r;
#pragma unroll
                for (int bj = 0; bj < 2; ++bj) { f32x4 v0 = acc[ai][bj][m][0] * r + (uv[bj][0] * mr + cv[bj][0]), v1 = acc[ai][bj][m][1] * r + (uv[bj][1] * mr + cv[bj][1]);
#pragma unroll
                    for (int e = 0; e < 4; ++e) { const float a = fmaxf(v0[e], 0.f), b = fmaxf(v1[e], 0.f); v0[e] = a * a; v1[e] = b * b; }
                    u32x4 w; w.x = cvt_pk_bf16(v0[0], v0[1]); w.y = cvt_pk_bf16(v0[2], v0[3]); w.z = cvt_pk_bf16(v1[0], v1[1]); w.w = cvt_pk_bf16(v1[2], v1[3]);
                    *(u32x4*)(rowp + bj * HALF) = w; } }
    }
};
struct EpiResidLn {
    static constexpr bool PERM = true, AFTER_DRAIN = false;
    const bf16_t* P; bf16_t* O; float* stats2; int ldc; const float* stats; const float* gvec; const float* bvec; float alpha, inv_n, eps;
    __device__ __forceinline__ void operator()(const f32x4 (&acc)[2][2][4][2], const Unit& u, int wr, int wc, int fr, int fq) const {
        const int row0 = u.pm * BM + wr * 64 + fr, col0 = u.pn * BM + wc * 32 + 8 * fq;
#pragma unroll
        for (int bj = 0; bj < 2; ++bj) {
            const f32x4 g0 = *(const f32x4*)(gvec + col0 + bj * HALF) * alpha, g1 = *(const f32x4*)(gvec + col0 + bj * HALF + 4) * alpha;
            const f32x4 b0 = *(const f32x4*)(bvec + col0 + bj * HALF) * alpha, b1 = *(const f32x4*)(bvec + col0 + bj * HALF + 4) * alpha;
#pragma unroll
            for (int ai = 0; ai < 2; ++ai) {
                u32x4 pz[4]; float mu[4], rs[4];
#pragma unroll
                for (int m = 0; m < 4; ++m) { const int row = row0 + ai * HALF + m * 16;
                    pz[m] = *(const u32x4*)(P + (size_t)row * ldc + col0 + bj * HALF);
                    const float s1 = stats[2 * row], s2 = stats[2 * row + 1]; mu[m] = s1 * inv_n; rs[m] = 1.0f / sqrtf(fmaxf(s2 * inv_n - mu[m] * mu[m], 0.f) + eps); }
#pragma unroll
                for (int m = 0; m < 4; ++m) { const int row = row0 + ai * HALF + m * 16; const u32x4 w = pz[m];
                    f32x4 p0, p1;
                    p0[0] = __uint_as_float(w.x << 16); p0[1] = __uint_as_float(w.x & 0xffff0000u); p0[2] = __uint_as_float(w.y << 16); p0[3] = __uint_as_float(w.y & 0xffff0000u);
                    p1[0] = __uint_as_float(w.z << 16); p1[1] = __uint_as_float(w.z & 0xffff0000u); p1[2] = __uint_as_float(w.w << 16); p1[3] = __uint_as_float(w.w & 0xffff0000u);
                    const f32x4 o0 = ((p0 - mu[m]) * rs[m]) * g0 + b0 + acc[ai][bj][m][0], o1 = ((p1 - mu[m]) * rs[m]) * g1 + b1 + acc[ai][bj][m][1];
                    float t1 = ((o0[0] + o0[1]) + (o0[2] + o0[3])) + ((o1[0] + o1[1]) + (o1[2] + o1[3]));
                    float t2 = ((o0[0] * o0[0] + o0[1] * o0[1]) + (o0[2] * o0[2] + o0[3] * o0[3])) + ((o1[0] * o1[0] + o1[1] * o1[1]) + (o1[2] * o1[2] + o1[3] * o1[3]));
                    u32x4 q; q.x = cvt_pk_bf16(o0[0], o0[1]); q.y = cvt_pk_bf16(o0[2], o0[3]); q.z = cvt_pk_bf16(o1[0], o1[1]); q.w = cvt_pk_bf16(o1[2], o1[3]);
                    *(u32x4*)(O + (size_t)row * ldc + col0 + bj * HALF) = q;
                    t1 += __shfl_xor(t1, 16); t2 += __shfl_xor(t2, 16); t1 += __shfl_xor(t1, 32); t2 += __shfl_xor(t2, 32);
                    if (fq == 0) { unsafeAtomicAdd(stats2 + 2 * row, t1); unsafeAtomicAdd(stats2 + 2 * row + 1, t2); } }
                asm volatile("" ::: "memory");
            }
        }
    }
};

template <class Epi, class Sched, bool ALIGN_EPI = false, bool SP2 = false>
__device__ __forceinline__ void gemm_phase(PG8_LAS unsigned char* lds, const Gemm g, const Sched& S, const Epi& E, int wid) {
    int lane_; asm volatile("v_mbcnt_lo_u32_b32 %0, -1, 0\n\tv_mbcnt_hi_u32_b32 %0, -1, %0" : "=v"(lane_));
    const int lane = lane_, tid = wid * 64 + lane, wr = wid >> 2, wc = wid & 3, fr = lane & 15, fq = lane >> 4;
    const int K = g.K, nt = K / BK;
    unsigned voffA[2], voffB[2];
#pragma unroll
    for (int i = 0; i < 2; ++i) { int R, C; stage_rc(tid * 16 + i * 8192, R, C); const int Rb = Epi::PERM ? ((R & ~31) + perm32(R & 31)) : R;
        voffA[i] = (unsigned)(R * K + C) * 2u; voffB[i] = (unsigned)(Rb * K + C) * 2u; }
    const size_t kstep = (size_t)(BK * 2);
    const size_t hstep = (size_t)HALF * K * 2;
    const size_t tstep = 2 * hstep;
    const unsigned ldsw = (unsigned)wid * 1024u;
    const int aoff = lds_byte(wr * 64 + fr, fq * 8), boff = lds_byte(wc * 32 + fr, fq * 8);
#define PG8_SA(b, h) (((b) * 2 + (h)) * HTB)
#define PG8_SB(b, h) ((4 + (b) * 2 + (h)) * HTB)
#define PG8_STAGE(bufoff, gbase, voff) do { _Pragma("unroll") for (int _i = 0; _i < 2; ++_i) \
        __builtin_amdgcn_global_load_lds((const unsigned*)((const char*)(gbase) + (voff)[_i]), (PG8_LAS unsigned*)(lds + (bufoff) + ldsw + _i * 8192), 16, 0, 0); } while (0)
#define PG8_LDA(dst, b, h) do { _Pragma("unroll") for (int m = 0; m < 4; ++m) _Pragma("unroll") for (int k = 0; k < 2; ++k) dst[m][k] = *(const PG8_LAS bf16x8*)(lds + PG8_SA(b, h) + aoff + m * 2048 + k * 1024); } while (0)
#define PG8_LDB(dst, b, h) do { _Pragma("unroll") for (int n = 0; n < 2; ++n) _Pragma("unroll") for (int k = 0; k < 2; ++k) dst[n][k] = *(const PG8_LAS bf16x8*)(lds + PG8_SB(b, h) + boff + n * 2048 + k * 1024); } while (0)
#define PG8_MMA(ai, bj, At, Bt) do { __builtin_amdgcn_s_setprio(1); _Pragma("unroll") for (int m = 0; m < 4; ++m) _Pragma("unroll") for (int n = 0; n < 2; ++n) _Pragma("unroll") for (int k = 0; k < 2; ++k) \
        acc[ai][bj][m][n] = __builtin_amdgcn_mfma_f32_16x16x32_bf16(Bt[n][k], At[m][k], acc[ai][bj][m][n], 0, 0, 0); __builtin_amdgcn_s_setprio(0); } while (0)
#define PG8_WAIT_V(n) asm volatile("s_waitcnt vmcnt(" #n ")" ::: "memory")
#define PG8_WAIT_L(n) asm volatile("s_waitcnt lgkmcnt(" #n ")" ::: "memory")
#define PG8_BAR __builtin_amdgcn_s_barrier()
#define PG8_SCHED __builtin_amdgcn_sched_barrier(0)
    Unit cur, nxt; int ui = 0;
    if (!S.next(0, cur)) return;
    f32x4 acc[2][2][4][2];
#pragma unroll
    for (int a = 0; a < 2; ++a)
#pragma unroll
        for (int b = 0; b < 2; ++b)
#pragma unroll
            for (int m = 0; m < 4; ++m)
#pragma unroll
                for (int n = 0; n < 2; ++n) acc[a][b][m][n] = (f32x4){0.f, 0.f, 0.f, 0.f};
    bf16x8 At[4][2], B0[2][2], B1[2][2];
    const char* cA = (const char*)g.A + (size_t)cur.pm * tstep; const char* cB = (const char*)g.Bt + (size_t)cur.pn * tstep;
    S.a_ready(cur);
    if constexpr (SP2) {
        PG8_STAGE(PG8_SB(0, 0), cB, voffB); PG8_STAGE(PG8_SB(0, 1), cB + hstep, voffB); PG8_STAGE(PG8_SA(0, 0), cA, voffA); PG8_STAGE(PG8_SA(0, 1), cA + hstep, voffA);
        if (wr == 1) PG8_BAR;
        PG8_WAIT_V(2); PG8_BAR;
        PG8_STAGE(PG8_SB(1, 0), cB + kstep, voffB); PG8_STAGE(PG8_SA(1, 0), cA + kstep, voffA); PG8_STAGE(PG8_SB(1, 1), cB + hstep + kstep, voffB);
        PG8_WAIT_V(6); PG8_BAR;
    } else {
        PG8_STAGE(PG8_SB(0, 0), cB, voffB); PG8_STAGE(PG8_SA(0, 0), cA, voffA); PG8_STAGE(PG8_SB(0, 1), cB + hstep, voffB); PG8_STAGE(PG8_SA(0, 1), cA + hstep, voffA);
        if (wr == 1) PG8_BAR;
        PG8_WAIT_V(4); PG8_BAR;
        PG8_STAGE(PG8_SB(1, 0), cB + kstep, voffB); PG8_STAGE(PG8_SA(1, 0), cA + kstep, voffA); PG8_STAGE(PG8_SB(1, 1), cB + hstep + kstep, voffB);
        PG8_WAIT_V(6); PG8_BAR;
    }
    for (;;) {
        const bool has_next = S.next(ui + 1, nxt);
        const char* nA = has_next ? (const char*)g.A + (size_t)nxt.pm * tstep : cA; const char* nB = has_next ? (const char*)g.Bt + (size_t)nxt.pn * tstep : cB;
        for (int t = 0; t < nt; t += 2) {
            const bool last = (t == nt - 2);
            const char* a1 = cA + (size_t)(t + 1) * kstep;
            const char* a2 = last ? nA : cA + (size_t)(t + 2) * kstep; const char* b2 = last ? nB : cB + (size_t)(t + 2) * kstep;
            const char* a3 = a2 + kstep; const char* b3 = b2 + kstep;
            if (last && has_next) S.a_ready(nxt);
            if constexpr (SP2) {
            PG8_LDB(B0, 0, 0); PG8_LDB(B1, 0, 1); PG8_SCHED; PG8_LDA(At, 0, 0); PG8_STAGE(PG8_SA(1, 1), a1 + hstep, voffA);
            PG8_WAIT_V(8); PG8_WAIT_L(0); PG8_BAR; PG8_MMA(0, 0, At, B0); PG8_MMA(0, 1, At, B1); PG8_BAR; PG8_SCHED;
            PG8_LDA(At, 0, 1); PG8_STAGE(PG8_SB(0, 0), b2, voffB); PG8_STAGE(PG8_SB(0, 1), b2 + hstep, voffB); PG8_STAGE(PG8_SA(0, 0), a2, voffA);
            PG8_WAIT_V(8); PG8_WAIT_L(0); PG8_BAR; PG8_MMA(1, 0, At, B0); PG8_MMA(1, 1, At, B1); PG8_BAR; PG8_SCHED;
            PG8_LDB(B0, 1, 0); PG8_LDB(B1, 1, 1); PG8_SCHED; PG8_LDA(At, 1, 0); PG8_STAGE(PG8_SA(0, 1), a2 + hstep, voffA);
            PG8_WAIT_V(8); PG8_WAIT_L(0); PG8_BAR; PG8_MMA(0, 0, At, B0); PG8_MMA(0, 1, At, B1); PG8_BAR; PG8_SCHED;
            PG8_LDA(At, 1, 1); PG8_STAGE(PG8_SB(1, 0), b3, voffB); PG8_STAGE(PG8_SB(1, 1), b3 + hstep, voffB); PG8_STAGE(PG8_SA(1, 0), a3, voffA);
            PG8_WAIT_V(8); PG8_WAIT_L(0); PG8_BAR; PG8_MMA(1, 0, At, B0); PG8_MMA(1, 1, At, B1); PG8_BAR; PG8_SCHED;
            } else {
            PG8_LDB(B0, 0, 0); PG8_SCHED; PG8_LDA(At, 0, 0); PG8_STAGE(PG8_SA(1, 1), a1 + hstep, voffA);
            PG8_WAIT_L(8); PG8_BAR; PG8_WAIT_L(0); PG8_MMA(0, 0, At, B0); PG8_BAR; PG8_SCHED;
            PG8_LDB(B1, 0, 1); PG8_STAGE(PG8_SB(0, 0), b2, voffB);
            PG8_BAR; PG8_WAIT_L(0); PG8_MMA(0, 1, At, B1); PG8_BAR;
            PG8_LDA(At, 0, 1); PG8_STAGE(PG8_SA(0, 0), a2, voffA);
            PG8_BAR; PG8_WAIT_L(0); PG8_MMA(1, 0, At, B0); PG8_BAR; PG8_SCHED;
            PG8_STAGE(PG8_SB(0, 1), b2 + hstep, voffB);
            PG8_WAIT_V(6); PG8_BAR; PG8_MMA(1, 1, At, B1); PG8_BAR;
            PG8_LDB(B0, 1, 0); PG8_SCHED; PG8_LDA(At, 1, 0); PG8_STAGE(PG8_SA(0, 1), a2 + hstep, voffA);
            PG8_WAIT_L(8); PG8_BAR; PG8_WAIT_L(0); PG8_MMA(0, 0, At, B0); PG8_BAR; PG8_SCHED;
            PG8_LDB(B1, 1, 1); PG8_STAGE(PG8_SB(1, 0), b3, voffB);
            PG8_BAR; PG8_WAIT_L(0); PG8_MMA(0, 1, At, B1); PG8_BAR;
            PG8_LDA(At, 1, 1); PG8_STAGE(PG8_SA(1, 0), a3, voffA);
            PG8_BAR; PG8_WAIT_L(0); PG8_MMA(1, 0, At, B0); PG8_BAR; PG8_SCHED;
            PG8_STAGE(PG8_SB(1, 1), b3 + hstep, voffB);
            PG8_WAIT_V(6); PG8_BAR; PG8_MMA(1, 1, At, B1); PG8_BAR;
            }
        }
        if constexpr (ALIGN_EPI) { if (wr == 0) PG8_BAR; }
        if constexpr (!Epi::AFTER_DRAIN) { E(acc, cur, wr, wc, fr, fq); S.done(cur); }
        if (!has_next) break;
#pragma unroll
        for (int a = 0; a < 2; ++a)
#pragma unroll
            for (int b = 0; b < 2; ++b)
#pragma unroll
                for (int m = 0; m < 4; ++m)
#pragma unroll
                    for (int n = 0; n < 2; ++n) acc[a][b][m][n] = (f32x4){0.f, 0.f, 0.f, 0.f};
        cur = nxt; cA = nA; cB = nB; ++ui;
        if constexpr (ALIGN_EPI) { if (wr == 1) PG8_BAR; }
    }
    PG8_WAIT_V(0);
    if constexpr (!ALIGN_EPI) { if (wr == 0) PG8_BAR; }
    PG8_BAR;
    if constexpr (Epi::AFTER_DRAIN) { E.fused(acc, cur, wr, wc, fr, fq, lds, wid, lane); S.done(cur); }
#undef PG8_SA
#undef PG8_SB
#undef PG8_STAGE
#undef PG8_LDA
#undef PG8_LDB
#undef PG8_MMA
#undef PG8_WAIT_V
#undef PG8_WAIT_L
#undef PG8_BAR
#undef PG8_SCHED
}
}
namespace att {
typedef unsigned short bf16;
typedef short bf16x8 __attribute__((ext_vector_type(8)));
typedef short s16x4 __attribute__((ext_vector_type(4)));
typedef float f32x16 __attribute__((ext_vector_type(16)));
typedef float f32x4 __attribute__((ext_vector_type(4)));
typedef unsigned u32x4 __attribute__((ext_vector_type(4)));
constexpr int D = 128, PITCH = 12288, NW = 8, QBLK = 32, KVBLK = 64, QB = NW * QBLK;
constexpr int SHM_V = KVBLK * D * 2, SHM_K = KVBLK * D * 2;
constexpr int SHM_V2 = 2 * SHM_V;
constexpr int OFF_K = 2 * SHM_V2, OFF_WS = OFF_K + 2 * SHM_K, OFF_BIAS = OFF_WS + NW * 64 * 4, OFF_MISC = OFF_BIAS + 384 * 4, LDS_BYTES = OFF_MISC + 64;
constexpr float THR = 8.f;
#define KSWZ(row, colB) ((row) * 256 + ((colB) ^ (((row) & 7) << 4)))
#define SBAR() __builtin_amdgcn_sched_barrier(0)
__device__ __forceinline__ int v_st(int k, int c) { const int kk = (k & ~0xC) | ((k & 4) << 1) | ((k & 8) >> 1); return ((kk >> 3) * 4 + (c >> 5)) * 512 + ((kk & 7) * 32 + (c & 31)) * 2; }
__device__ __forceinline__ int v_rd_base(int lane) { return ((lane & 3) << 3) | (((lane >> 2) & 3) << 6) | (((lane >> 4) & 1) << 5) | (((lane >> 5) & 1) << 8); }
constexpr int v_rd_off(int d0, int ks, int half) { return d0 * 512 + ks * 4096 + half * 2048; }
__device__ __forceinline__ int crow(int r, int hi) { return (r & 3) + 8 * (r >> 2) + 4 * hi; }
__device__ __forceinline__ unsigned cvtpk(float lo, float hi) { unsigned r; asm volatile("v_cvt_pk_bf16_f32 %0, %1, %2" : "=v"(r) : "v"(lo), "v"(hi)); return r; }
__device__ __forceinline__ bf16x8 load8(const bf16* p) { return *reinterpret_cast<const bf16x8*>(p); }
__device__ __forceinline__ void mask_tile(f32x16& p0, f32x16& p1, int dq) {
    const float NEG = -__builtin_inff();
#pragma unroll
    for (int r = 0; r < 16; ++r) { const int c = (r & 3) + 8 * (r >> 2); if (dq - c < 0) p0[r] = NEG; if (dq - c - 32 < 0) p1[r] = NEG; }
}
__device__ __forceinline__ void bias_tile(f32x16& p0, f32x16& p1, int dq, const float* T) {
    const float* tp = T + dq;
#pragma unroll
    for (int r = 0; r < 16; ++r) { const int c = (r & 3) + 8 * (r >> 2); p0[r] += tp[128 - c]; p1[r] += tp[96 - c]; }
}
#define ATT_PK4(P, B_, OUT) do { unsigned a0 = cvtpk(P[B_+0], P[B_+1]), a1 = cvtpk(P[B_+2], P[B_+3]);                          \
        unsigned b0 = cvtpk(P[B_+4], P[B_+5]), b1 = cvtpk(P[B_+6], P[B_+7]);                                             \
        auto r0 = __builtin_amdgcn_permlane32_swap(a0, b0, false, false); auto r1 = __builtin_amdgcn_permlane32_swap(a1, b1, false, false); \
        u32x4 w = {r0[0], r1[0], r0[1], r1[1]}; OUT = *reinterpret_cast<bf16x8*>(&w); } while (0)
__device__ __forceinline__ void softmax_tile(f32x16& p0, f32x16& p1, float& m_reg, float& l_reg, float& alpha, bf16x8& pa0, bf16x8& pa1, bf16x8& pa2, bf16x8& pa3) {
    float pmax = p0[0]; for (int r = 1; r < 16; ++r) pmax = fmaxf(pmax, p0[r]); for (int r = 0; r < 16; ++r) pmax = fmaxf(pmax, p1[r]);
    { auto rr = __builtin_amdgcn_permlane32_swap(__float_as_uint(pmax), __float_as_uint(pmax), false, false);
      pmax = fmaxf(__uint_as_float(rr[0]), __uint_as_float(rr[1])); }
    float mn;
    if (__builtin_expect(__all((pmax - m_reg) <= THR), 1)) { mn = m_reg; alpha = 1.f; }
    else { mn = fmaxf(m_reg, pmax); alpha = __builtin_amdgcn_exp2f(m_reg - mn); m_reg = mn; }
    for (int r = 0; r < 16; ++r) p0[r] = __builtin_amdgcn_exp2f(p0[r] - mn);
    for (int r = 0; r < 16; ++r) p1[r] = __builtin_amdgcn_exp2f(p1[r] - mn);
    float ps = 0; for (int r = 0; r < 16; ++r) ps += p0[r]; for (int r = 0; r < 16; ++r) ps += p1[r];
    { auto rr = __builtin_amdgcn_permlane32_swap(__float_as_uint(ps), __float_as_uint(ps), false, false);
      ps = __uint_as_float(rr[0]) + __uint_as_float(rr[1]); }
    l_reg = l_reg * alpha + ps;
    ATT_PK4(p0, 0, pa0); ATT_PK4(p0, 8, pa1); ATT_PK4(p1, 0, pa2); ATT_PK4(p1, 8, pa3);
}
template <int KB>
__device__ __forceinline__ void qkt(f32x16& p0, f32x16& p1, const char* K_lds, int r32, int hi, const bf16x8* qr) {
    p0 = f32x16{}; p1 = f32x16{};
    const char* kb[4];
#pragma unroll
    for (int dd = 0; dd < 4; ++dd) kb[dd] = K_lds + KB * SHM_K + KSWZ(r32, (dd * 16 + hi * 8) * 2);
#pragma unroll
    for (int d0 = 0; d0 < 8; d0 += 2) {
        const char* a0 = kb[d0 & 3] + (d0 >> 2) * 128; const char* a1 = kb[(d0 + 1) & 3] + ((d0 + 1) >> 2) * 128;
        const bf16x8 b00 = *reinterpret_cast<const bf16x8*>(a0), b01 = *reinterpret_cast<const bf16x8*>(a0 + 32 * 256);
        const bf16x8 b10 = *reinterpret_cast<const bf16x8*>(a1), b11 = *reinterpret_cast<const bf16x8*>(a1 + 32 * 256);
        p0 = __builtin_amdgcn_mfma_f32_32x32x16_bf16(b00, qr[d0], p0, 0, 0, 0);
        p1 = __builtin_amdgcn_mfma_f32_32x32x16_bf16(b01, qr[d0], p1, 0, 0, 0);
        p0 = __builtin_amdgcn_mfma_f32_32x32x16_bf16(b10, qr[d0 + 1], p0, 0, 0, 0);
        p1 = __builtin_amdgcn_mfma_f32_32x32x16_bf16(b11, qr[d0 + 1], p1, 0, 0, 0);
        SBAR(); }
}
#define ATT_TRRD(dst, base, off) asm volatile("ds_read_b64_tr_b16 %0, %1 offset:%2" : "=&v"(dst) : "v"(base), "i"(off) : "memory")
template <int VB>
__device__ __forceinline__ void pv_tile(f32x16* o, int vb0, bf16x8 pa0, bf16x8 pa1, bf16x8 pa2, bf16x8 pa3) {
#define PV_D0(d0) do { s16x4 l0, l1, l2, l3, h0, h1, h2, h3; constexpr int b_ = VB * SHM_V2 + ((d0) >> 2) * SHM_V + v_rd_off((d0) & 3, 0, 0); \
        ATT_TRRD(l0, vb0, b_); ATT_TRRD(h0, vb0, b_ + 2048); ATT_TRRD(l1, vb0, b_ + 4096); ATT_TRRD(h1, vb0, b_ + 6144); ATT_TRRD(l2, vb0, b_ + 8192); ATT_TRRD(h2, vb0, b_ + 10240); ATT_TRRD(l3, vb0, b_ + 12288); ATT_TRRD(h3, vb0, b_ + 14336); \
        asm volatile("s_waitcnt lgkmcnt(0)" ::: "memory"); SBAR();   \
        o[d0] = __builtin_amdgcn_mfma_f32_32x32x16_bf16(pa0, (bf16x8){l0[0], l0[1], l0[2], l0[3], h0[0], h0[1], h0[2], h0[3]}, o[d0], 0, 0, 0);   \
        o[d0] = __builtin_amdgcn_mfma_f32_32x32x16_bf16(pa1, (bf16x8){l1[0], l1[1], l1[2], l1[3], h1[0], h1[1], h1[2], h1[3]}, o[d0], 0, 0, 0);   \
        o[d0] = __builtin_amdgcn_mfma_f32_32x32x16_bf16(pa2, (bf16x8){l2[0], l2[1], l2[2], l2[3], h2[0], h2[1], h2[2], h2[3]}, o[d0], 0, 0, 0);   \
        o[d0] = __builtin_amdgcn_mfma_f32_32x32x16_bf16(pa3, (bf16x8){l3[0], l3[1], l3[2], l3[3], h3[0], h3[1], h3[2], h3[3]}, o[d0], 0, 0, 0); } while (0)
    PV_D0(0); PV_D0(1); PV_D0(2); PV_D0(3); PV_D0(4); PV_D0(5); PV_D0(6); PV_D0(7);
#undef PV_D0
}
struct BlockRef { const bf16* Q; const bf16* K; const bf16* V; float* O; bf16* mixrow; int P0; int m; };
#define ROW(p, k0, rr) ((p) + (size_t)((k0) + (rr)) * PITCH + sc)
#define VMW() asm volatile("s_waitcnt vmcnt(0)" ::: "memory")
__device__ __forceinline__ float ld_sc1(const float* p) { return __uint_as_float(__hip_atomic_load((const unsigned*)p, __ATOMIC_RELAXED, __HIP_MEMORY_SCOPE_AGENT)); }
typedef __attribute__((address_space(3))) unsigned char* lds_ptr;
__device__ __forceinline__ void block(const BlockRef& cur, lds_ptr ldsa, float lam, const float* gain, float oscale, int wid) {
    int lane_; asm volatile("v_mbcnt_lo_u32_b32 %0, -1, 0\n\tv_mbcnt_hi_u32_b32 %0, -1, %0" : "=v"(lane_));
    const int lane = lane_, tid = wid * 64 + lane, r32 = lane & 31, hi = lane >> 5;
    char* lds = (char*)ldsa;
    const int NT = (cur.P0 + QB) / KVBLK;
    const int qlo = cur.P0 + wid * QBLK, qm = qlo + r32 - 4 * hi;
    char* V_lds = lds; char* K_lds = lds + OFF_K;
    float* ws = (float*)(lds + OFF_WS) + wid * 64; float* li_l = ws, * al_l = ws + 32;
    const float* bias_l = (const float*)(lds + OFF_BIAS);
    const int vb0 = (int)(uintptr_t)V_lds + v_rd_base(lane);
    const bf16* Kh = cur.K; const bf16* Vh = cur.V;
    unsigned koff[2], voff[2];
#pragma unroll
    for (int j = 0; j < 2; ++j) { const int pc = wid + 8 * j;
        { const int row = 4 * pc + (lane >> 4), c16 = (lane & 15) ^ (row & 7); koff[j] = (unsigned)(row * PITCH + c16 * 8) * 2u; }
        { const int sb = 2 * pc + (lane >> 5), kk = (sb >> 2) * 8 + ((lane & 31) >> 2), c = (sb & 3) * 32 + (lane & 3) * 8, k = (kk & ~0xC) | ((kk & 4) << 1) | ((kk & 8) >> 1);
          voff[j] = (unsigned)(k * PITCH + c) * 2u; } }
#define DMA16(gp, loff) __builtin_amdgcn_global_load_lds((const unsigned*)(gp), (__attribute__((address_space(3))) unsigned*)(ldsa + (loff)), 16, 0, 0)
#define STAGE(k0, bf) do { const char* vt_ = (const char*)(Vh + (size_t)(k0) * PITCH); const char* kt_ = (const char*)(Kh + (size_t)(k0) * PITCH); \
        _Pragma("unroll") for (int j_ = 0; j_ < 2; ++j_) { const int pc_ = (wid + 8 * j_) * 1024; \
            DMA16(kt_ + koff[j_], OFF_K + (bf) * SHM_K + pc_); DMA16(vt_ + voff[j_], (bf) * SHM_V2 + pc_); DMA16(vt_ + voff[j_] + 256, (bf) * SHM_V2 + SHM_V + pc_); } } while (0)
    STAGE(0, 0);
    bf16x8 qr[8];
#pragma unroll
    for (int d0 = 0; d0 < 8; ++d0) qr[d0] = load8(cur.Q + (size_t)(wid * QBLK + r32) * PITCH + d0 * 16 + hi * 8);
    VMW();
    __syncthreads();
    float m_reg = -1e30f, l_reg = 0; f32x16 o[8] = {};
#define KBASE(t) ((t) * KVBLK)
#define MASKT(P0_, P1_, t) do { const int kb_ = KBASE(t); if (kb_ + KVBLK - 1 > qlo - 128 && kb_ <= qlo + QBLK - 1) bias_tile(P0_, P1_, qm - kb_, bias_l); \
                                if (kb_ + KVBLK - 1 > qlo) mask_tile(P0_, P1_, qm - kb_); } while (0)
#define STEP(t, BF, SB) do { f32x16 p0, p1; float alpha; bf16x8 pa0, pa1, pa2, pa3;                                      \
        if ((t) + 1 < NT) { STAGE(KBASE((t) + 1), SB); } SBAR();                                                          \
        if (KBASE(t) <= qlo + QBLK - 1) {        \
        qkt<BF>(p0, p1, K_lds, r32, hi, qr); SBAR();                                                                     \
        MASKT(p0, p1, (t)); softmax_tile(p0, p1, m_reg, l_reg, alpha, pa0, pa1, pa2, pa3);                               \
        if (__any(alpha < 1.f)) { if (hi == 0) al_l[r32] = alpha; asm volatile("s_waitcnt lgkmcnt(0)" ::: "memory");      \
            for (int d_ = 0; d_ < 8; ++d_) for (int r = 0; r < 16; ++r) o[d_][r] *= al_l[crow(r, hi)]; }                  \
        SBAR(); pv_tile<BF>(o, vb0, pa0, pa1, pa2, pa3); SBAR(); }                                                        \
        VMW(); __syncthreads(); } while (0)
    for (int t = 0; t < NT; t += 2) { STEP(t, 0, 1); STEP(t + 1, 1, 0); }
    if (hi == 0) li_l[r32] = l_reg; asm volatile("s_waitcnt lgkmcnt(0)" ::: "memory");
    float* Ow = cur.O + (size_t)(wid * QBLK) * 256 + lane * 4;
    if (cur.m == 0) {
#pragma unroll
        for (int r = 0; r < 16; ++r) { const int orow = crow(r, hi); const float rl = __builtin_amdgcn_rcpf(li_l[orow]);
#pragma unroll
            for (int dq = 0; dq < 2; ++dq) { const f32x4 w = {o[4 * dq][r] * rl, o[4 * dq + 1][r] * rl, o[4 * dq + 2][r] * rl, o[4 * dq + 3][r] * rl};
                *(f32x4*)(Ow + (r * 2 + dq) * 256) = w; } }
    } else {
        VMW();
        float g[8];
#pragma unroll
        for (int d0 = 0; d0 < 8; ++d0) g[d0] = gain[d0 * 32 + r32] * oscale;
        bf16* mw = cur.mixrow + (size_t)(wid * QBLK) * 4096 + r32;
#pragma unroll
        for (int rg = 0; rg < 16; rg += 4) {
            float v[4][8];
            { f32x4 t[4][2];
#pragma unroll
              for (int q = 0; q < 4; ++q)
#pragma unroll
                  for (int dq = 0; dq < 2; ++dq) asm volatile("global_load_dwordx4 %0, %1, off sc1" : "=&v"(t[q][dq]) : "v"(Ow + ((rg + q) * 2 + dq) * 256) : "memory");
              asm volatile("s_waitcnt vmcnt(0)" : "+v"(t[0][0]), "+v"(t[0][1]), "+v"(t[1][0]), "+v"(t[1][1]), "+v"(t[2][0]), "+v"(t[2][1]), "+v"(t[3][0]), "+v"(t[3][1]) :: "memory");
#pragma unroll
              for (int q = 0; q < 4; ++q)
#pragma unroll
                  for (int dq = 0; dq < 2; ++dq) { v[q][4 * dq] = t[q][dq][0]; v[q][4 * dq + 1] = t[q][dq][1]; v[q][4 * dq + 2] = t[q][dq][2]; v[q][4 * dq + 3] = t[q][dq][3]; } }
#pragma unroll
            for (int q = 0; q < 4; ++q) { const int r = rg + q, orow = crow(r, hi); const float rl = lam * __builtin_amdgcn_rcpf(li_l[orow]);
                float ss = 0.f;
#pragma unroll
                for (int d0 = 0; d0 < 8; ++d0) { v[q][d0] -= o[d0][r] * rl; ss += v[q][d0] * v[q][d0]; }
#pragma unroll
                for (int sft = 1; sft < 32; sft <<= 1) ss += __shfl_xor(ss, sft);
                const float rs = 1.0f / sqrtf(ss * (1.0f / 256.0f) + 1e-5f);
#pragma unroll
                for (int d0 = 0; d0 < 8; ++d0) { const float y = v[q][d0] * rs * g[d0]; const float yn = __shfl_xor(y, 1);
                    if ((r32 & 1) == 0) *(unsigned*)(mw + (size_t)orow * 4096 + d0 * 32) = cvtpk(y, yn); } }
            asm volatile("" ::: "memory"); }
    }
    __syncthreads();
#undef DMA16
#undef STAGE
#undef KBASE
#undef MASKT
#undef STEP
}
#undef ROW
#undef VMW
}

constexpr int NWAVES = 8;
#ifndef MK_N_LAUNCHES
#define MK_N_LAUNCHES 1
#endif
constexpr int N_PHASES = 8;
constexpr int N_LAUNCHES = MK_N_LAUNCHES;
static_assert(N_LAUNCHES == 1 || N_LAUNCHES == N_PHASES, "MK_N_LAUNCHES is 1 or N_PHASES");

constexpr int SEQ = 8192, DM = 4096, M = 2 * SEQ, NPROJ = 12288, DFF = 16384;
constexpr int C_AQ = 0, C_AK = 2048, C_AV = 4096, C_RQ = 6144, C_RK = 7168, C_RV = 8192, C_RG = 10240;
constexpr float LN_EPS = 1e-5f;
constexpr float ALPHA = 1.189207115002721f;
constexpr float LAMBDA_INIT = 0.3555090675732191f;
constexpr float LOG2E = 1.4426950408889634f;

constexpr size_t MiB = 1u << 20;
constexpr size_t WS_CTL = 0, CTL_ZERO_BYTES = 1 * MiB;
constexpr size_t WS_STATS = 65536;
constexpr size_t WS_UVEC = 196608;
constexpr size_t WS_CVEC = 262144;
constexpr size_t WS_STATS2 = 327680;
constexpr size_t WS_QUEUE = 458752;
constexpr size_t WS_ROPE = 1 * MiB;
constexpr size_t WS_DEC = 5 * MiB;
constexpr size_t WS_W1T = 8 * MiB;
constexpr size_t WS_PRE2 = 8 * MiB;
constexpr size_t WS_W2T = 136 * MiB;
constexpr size_t WS_XB = 264 * MiB;
constexpr size_t WS_SST = 264 * MiB;
constexpr size_t WS_RG = 328 * MiB;
constexpr size_t WS_PRE1 = 264 * MiB;
constexpr size_t WS_WINT = 392 * MiB;
constexpr size_t WS_MIX = 392 * MiB;
constexpr size_t WS_WOT = 520 * MiB;
constexpr size_t WS_PROJ = 552 * MiB;
constexpr size_t WS_ASCR = 936 * MiB;
constexpr size_t WS_H = 512 * MiB;
constexpr size_t WS_END = 1024 * MiB;
constexpr int CW_TMO = 0, CW_BAR = 4096;

constexpr int RING_OFF = 0, RING_BYTES = 131072;
constexpr int LDSCTL_OFF = RING_BYTES, MISC_OFF = LDSCTL_OFF + 320;
constexpr int LDS_BYTES = 147456;
static_assert(att::LDS_BYTES <= RING_BYTES, "attention LDS");

#define GAS __attribute__((address_space(1)))
#define LAS __attribute__((address_space(3)))
typedef unsigned short bf16;
typedef unsigned v4u __attribute__((ext_vector_type(4)));
typedef unsigned v2u __attribute__((ext_vector_type(2)));
typedef float f32x4 __attribute__((ext_vector_type(4)));
typedef float f32x16 __attribute__((ext_vector_type(16)));
typedef short bf16x8 __attribute__((ext_vector_type(8)));
typedef short s16x4 __attribute__((ext_vector_type(4)));
typedef GAS unsigned gu32;
typedef unsigned u32x4 __attribute__((ext_vector_type(4)));
using att::cvtpk;
#define RLX_AGENT __ATOMIC_RELAXED, __HIP_MEMORY_SCOPE_AGENT
#define LDS_WAIT() asm volatile("s_waitcnt lgkmcnt(0)" ::: "memory")
#define VM_WAIT() asm volatile("s_waitcnt vmcnt(0)" ::: "memory")
__device__ __forceinline__ unsigned f2bf(float f) { unsigned u = __builtin_bit_cast(unsigned, f); return (u + 0x7fffu + ((u >> 16) & 1u)) >> 16; }
__device__ __forceinline__ unsigned pk2(float lo, float hi) { return f2bf(lo) | (f2bf(hi) << 16); }
__device__ __forceinline__ float bf2f(unsigned short b) { return __builtin_bit_cast(float, (unsigned)b << 16); }

#define XB_TMO      128
#define XB_XCNT(j)  (256  + 64 * (j))
#define XB_XSUB(j)  (1280 + 64 * (j))
#define XB_XGEN(j)  (2304 + 64 * (j))
#define XB_TOP      3328
#define XB_TOPGEN   3392
#define XCD_BAR_WORDS 3456
#define XB_SPIN_CAP (1u << 18)

__device__ __forceinline__ unsigned xb_ld(unsigned* p)              { return __hip_atomic_load(p, __ATOMIC_RELAXED, __HIP_MEMORY_SCOPE_AGENT); }
__device__ __forceinline__ unsigned xb_add(unsigned* p, unsigned v) { return __hip_atomic_fetch_add(p, v, __ATOMIC_RELAXED, __HIP_MEMORY_SCOPE_AGENT); }
__device__ __forceinline__ unsigned xb_xcc_id() { return (unsigned)__builtin_amdgcn_s_getreg((3 << 11) | 20) & 0xFu; }
#define XB_SPIN(cond, bar) do { unsigned _sp = 0; while (cond) { __builtin_amdgcn_s_sleep(1); \
    if ((++_sp & 255u) == 0u) { if (xb_ld(&(bar)[XB_TMO])) break; if (_sp > XB_SPIN_CAP) { atomicAdd(&(bar)[XB_TMO], 1u); break; } } } } while (0)

struct XcdBarrier {
    unsigned* bar; unsigned x;
    volatile LAS unsigned* st;
};

__device__ __forceinline__ XcdBarrier xcd_barrier_post(unsigned* bar, volatile LAS unsigned* st, bool t0) {
    XcdBarrier b; b.bar = bar; b.x = xb_xcc_id(); b.st = st;
    if (t0) (void)xb_add(&bar[XB_XCNT(b.x)], 1u);
    return b;
}
__device__ __forceinline__ void xcd_barrier_complete(unsigned* bar, unsigned x, unsigned& nloc, unsigned& nx) {
    const unsigned G = gridDim.x * gridDim.y * gridDim.z;
    unsigned sum, cnt, mine, sp = 0u;
    for (;;) {
        sum = 0u; cnt = 0u; mine = 0u;
#pragma unroll
        for (unsigned j = 0; j < 16; ++j) { const unsigned c = xb_ld(&bar[XB_XCNT(j)]); sum += c; cnt += (c > 0u) ? 1u : 0u; mine = (j == x) ? c : mine; }
        if (sum == G) break;
        __builtin_amdgcn_s_sleep(1);
        if ((++sp & 255u) == 0u) { if (xb_ld(&bar[XB_TMO])) break; if (sp > XB_SPIN_CAP) { atomicAdd(&bar[XB_TMO], 1u); break; } }
    }
    nloc = mine > 0u ? mine : 1u; nx = cnt > 0u ? cnt : 1u;
}

__device__ __forceinline__ void xcd_barrier(const XcdBarrier& b, bool t0) {
    asm volatile("s_waitcnt vmcnt(0)" ::: "memory");
    __syncthreads();
    if (t0) {
        unsigned* bar = b.bar;
        __builtin_amdgcn_s_waitcnt(0);
        unsigned nloc = b.st[0], nx = b.st[1];
        if (nloc == 0u) { xcd_barrier_complete(bar, b.x, nloc, nx); b.st[0] = nloc; b.st[1] = nx; }
        const unsigned old = xb_add(&bar[XB_XSUB(b.x)], 1u);
        const unsigned gen = old / nloc;
        if (old + 1u == (gen + 1u) * nloc) {
            __builtin_amdgcn_fence(__ATOMIC_RELEASE, "agent");
            asm volatile("s_waitcnt vmcnt(0)" ::: "memory");
            const unsigned og = xb_add(&bar[XB_TOP], 1u);
            const unsigned tg = og / nx;
            if (og + 1u == (tg + 1u) * nx) xb_add(&bar[XB_TOPGEN], 1u);
            else XB_SPIN(xb_ld(&bar[XB_TOPGEN]) == tg, bar);
            __builtin_amdgcn_fence(__ATOMIC_ACQUIRE, "agent");
            xb_add(&bar[XB_XGEN(b.x)], 1u);
            asm volatile("s_waitcnt vmcnt(0)" ::: "memory");
        } else {
            XB_SPIN(xb_ld(&bar[XB_XGEN(b.x)]) == gen, bar);
            __builtin_amdgcn_fence(__ATOMIC_ACQUIRE, "agent");
            asm volatile("s_waitcnt vmcnt(0)" ::: "memory");
        }
    }
    __syncthreads();
}

struct Frame {
    LAS unsigned char* lds;
    volatile LAS unsigned* MISC;
    gu32* ctl;
    int tid, lane, wave;
    int vcu, G;
};
__device__ __forceinline__ float wave_sum(float v) {
#pragma unroll
    for (int o = 1; o < 64; o <<= 1) v += __shfl_xor(v, o);
    return v;
}
__device__ __forceinline__ void refresh_ids(Frame& F) { int l; asm volatile("v_mbcnt_lo_u32_b32 %0, -1, 0\n\tv_mbcnt_hi_u32_b32 %0, -1, %0" : "=v"(l)); F.lane = l; F.tid = F.wave * 64 + l; }
__device__ const unsigned char T5_BUCKET[128] = {0, 1, 2, 3, 4, 5, 6, 7, 8, 9, 10, 11, 12, 13, 14, 15, 16, 16, 16, 17, 17, 18, 18, 18, 19, 19, 19, 20, 20, 20, 20, 21, 21, 21, 21, 22, 22, 22, 22, 22, 23, 23, 23, 23, 23, 23, 24, 24, 24, 24, 24, 24, 25, 25, 25, 25, 25, 25, 25, 26, 26, 26, 26, 26, 26, 26, 26, 27, 27, 27, 27, 27, 27, 27, 27, 27, 27, 28, 28, 28, 28, 28, 28, 28, 28, 28, 28, 29, 29, 29, 29, 29, 29, 29, 29, 29, 29, 29, 29, 30, 30, 30, 30, 30, 30, 30, 30, 30, 30, 30, 30, 30, 30, 31, 31, 31, 31, 31, 31, 31, 31, 31, 31, 31, 31, 31, 31, 31};

__device__ __forceinline__ int win_dest_row(int n) {
    if (n >= C_RQ && n < C_RV) { const int r = n - C_RQ, hb = r & ~127, i = r & 127; return C_RQ + hb + (i < 64 ? 2 * i : 2 * (i - 64) + 1); }
    return n;
}
__device__ __forceinline__ void p0_item_load(const float* W, int N, int item, int lane, f32x4 (&v)[8]) {
    const int nblk = N / 32, kb = item / nblk, nb = item % nblk, k0 = 64 * kb, n0 = 32 * nb;
#pragma unroll
    for (int i = 0; i < 8; ++i) { const int kk = 8 * i + (lane >> 3); v[i] = *(const GAS f32x4*)(W + (size_t)(k0 + kk) * N + n0 + (lane & 7) * 4); }
}
template <bool FOLD>
__device__ __forceinline__ void p0_item_body(const f32x4 (&v)[8], int K, int N, bf16* WT, LAS float* scr, int item, int lane, bool permute, const float* gvec, const float* bvec, float* uvec, float* cvec) {
    const int nblk = N / 32, kb = item / nblk, nb = item % nblk, k0 = 64 * kb, n0 = 32 * nb;
#pragma unroll
    for (int i = 0; i < 8; ++i) { const int kk = 8 * i + (lane >> 3); LAS float* s = scr + kk * 33 + (lane & 7) * 4; s[0] = v[i].x; s[1] = v[i].y; s[2] = v[i].z; s[3] = v[i].w; }
    LDS_WAIT(); asm volatile("" ::: "memory");
    const int c = lane & 7;
    float gk[8], bk[8];
    if constexpr (FOLD) {
#pragma unroll
        for (int j = 0; j < 2; ++j) { const f32x4 gq_ = *(const GAS f32x4*)(gvec + k0 + 8 * c + 4 * j), bq_ = *(const GAS f32x4*)(bvec + k0 + 8 * c + 4 * j);
            gk[4 * j] = gq_.x; gk[4 * j + 1] = gq_.y; gk[4 * j + 2] = gq_.z; gk[4 * j + 3] = gq_.w; bk[4 * j] = bq_.x; bk[4 * j + 1] = bq_.y; bk[4 * j + 2] = bq_.z; bk[4 * j + 3] = bq_.w; }
    }
#pragma unroll
    for (int j = 0; j < 4; ++j) { const int n = (lane >> 3) + 8 * j; const LAS float* s = scr + (8 * c) * 33 + n;
        float w[8];
#pragma unroll
        for (int q = 0; q < 8; ++q) w[q] = s[q * 33];
        v4u o;
        if constexpr (FOLD) {
            float cs = 0.f, us = 0.f; unsigned r[8];
#pragma unroll
            for (int q = 0; q < 8; ++q) { cs += bk[q] * w[q]; r[q] = f2bf(gk[q] * w[q]); us += __uint_as_float(r[q] << 16); }
            o.x = r[0] | (r[1] << 16); o.y = r[2] | (r[3] << 16); o.z = r[4] | (r[5] << 16); o.w = r[6] | (r[7] << 16);
            us += __shfl_xor(us, 1); cs += __shfl_xor(cs, 1); us += __shfl_xor(us, 2); cs += __shfl_xor(cs, 2); us += __shfl_xor(us, 4); cs += __shfl_xor(cs, 4);
            if (c == 0) { unsafeAtomicAdd(uvec + n0 + n, us); unsafeAtomicAdd(cvec + n0 + n, cs); }
        } else { o.x = pk2(w[0], w[1]); o.y = pk2(w[2], w[3]); o.z = pk2(w[4], w[5]); o.w = pk2(w[6], w[7]); }
        int nd = n0 + n; if (permute) nd = win_dest_row(nd);
        *(GAS v4u*)(WT + (size_t)nd * K + k0 + 8 * c) = o; }
    LDS_WAIT(); asm volatile("" ::: "memory");
}
template <bool FOLD>
__device__ __forceinline__ void p0_transpose_item(const float* W, int K, int N, bf16* WT, LAS float* scr, int item, int lane, bool permute, const float* gvec, const float* bvec, float* uvec, float* cvec) {
    f32x4 v[8]; p0_item_load(W, N, item, lane, v);
    p0_item_body<FOLD>(v, K, N, WT, scr, item, lane, permute, gvec, bvec, uvec, cvec);
}
template <bool FOLD>
__device__ __forceinline__ void p0_transpose_pair(const float* W, int K, int N, bf16* WT, LAS float* scr, int item0, int item1, int lane, const float* gvec, const float* bvec, float* uvec, float* cvec) {
    f32x4 v0[8], v1[8]; p0_item_load(W, N, item0, lane, v0); p0_item_load(W, N, item1, lane, v1);
    p0_item_body<FOLD>(v0, K, N, WT, scr, item0, lane, false, gvec, bvec, uvec, cvec);
    p0_item_body<FOLD>(v1, K, N, WT, scr, item1, lane, false, gvec, bvec, uvec, cvec);
}
struct P0Args { const float *x, *w_in, *w_out, *w1, *w2, *ln1_g, *ln1_b; bf16 *xb, *winT, *woT, *w1T, *w2T; float *rope, *dec, *uvec, *cvec; unsigned* queue; };
__device__ __forceinline__ void p0_prologue(Frame& F, const P0Args& A) {
    LAS float* scr = (LAS float*)(F.lds + RING_OFF + F.wave * 16384);
    volatile LAS unsigned* slot = F.MISC + 16;
    constexpr int I_IN = (DM / 64) * (NPROJ / 32);
    constexpr int NT_ITEMS = I_IN, NX_ITEMS = (int)((size_t)M * DM / 2048), NITEMS = NT_ITEMS + NX_ITEMS;
    static_assert(NITEMS % 8 == 0, "whole rounds");
    unsigned nxt = 0;
    if (F.tid == 0) nxt = __hip_atomic_fetch_add(A.queue, 8u, __ATOMIC_RELAXED, __HIP_MEMORY_SCOPE_AGENT);
    for (int rnd = 0;; ++rnd) {
        if (F.tid == 0) { slot[rnd & 1] = nxt; nxt = __hip_atomic_fetch_add(A.queue, 8u, __ATOMIC_RELAXED, __HIP_MEMORY_SCOPE_AGENT); }
        __syncthreads();
        const unsigned base = slot[rnd & 1];
        if (base >= (unsigned)NITEMS) break;
        int r = (int)base + F.wave;
        if (r < NT_ITEMS) {
            p0_transpose_item<false>(A.w_in, DM, NPROJ, A.winT, scr, r, F.lane, true, nullptr, nullptr, nullptr, nullptr);
        } else {
            const size_t i = (size_t)(r - NT_ITEMS) * 512 + F.lane; const GAS f32x4* xs = (const GAS f32x4*)A.x; GAS v2u* xd = (GAS v2u*)A.xb;
            f32x4 a[8];
#pragma unroll
            for (int j = 0; j < 8; ++j) a[j] = xs[i + 64 * j];
#pragma unroll
            for (int j = 0; j < 8; ++j) { v2u o; o.x = pk2(a[j].x, a[j].y); o.y = pk2(a[j].z, a[j].w); xd[i + 64 * j] = o; }
        }
    }
    const int gw = F.vcu * NWAVES + F.wave, NGW = F.G * NWAVES;
    { const int gt = gw * 64 + F.lane, NT = NGW * 64;
      for (int e = gt; e < SEQ * 64; e += NT) { const int pos = e >> 6, i = e & 63;
          const float t = (float)i * (1.0f / 63.0f); const float inv = 1.0f / powf(10000.0f, t); const float ang = (float)pos * inv;
          A.rope[2 * e] = cosf(ang); A.rope[2 * e + 1] = sinf(ang); }
      for (int e = gt; e < 8 * 128; e += NT) { const int h = e >> 7, c = e & 127;
          const float lg = log1pf(-exp2f(-5.0f - (float)h));
          A.dec[2 * e] = expf((float)c * lg); A.dec[2 * e + 1] = expf(-(float)c * lg) * 0.08838834764831845f; } }
}

__device__ __forceinline__ void p0_deferred(Frame& F, const P0Args& A) {
    LAS float* scr = (LAS float*)(F.lds + RING_OFF + F.wave * 16384);
    constexpr int I_O = (DM / 64) * (DM / 32), I_1 = (DM / 64) * (DFF / 32), I_2 = (DFF / 64) * (DM / 32);
    const int first = F.vcu * 8 + F.wave, step = F.G * 8, lane = F.lane;
#define DEF_MATRIX(FOLD_, Wp, K_, N_, WTp, I_, G_, B_, U_, C_) do { \
        int it = first; f32x4 a0[8], a1[8], b0[8], b1[8]; \
        bool ha = it < (I_); if (ha) { p0_item_load(Wp, N_, it, lane, a0); if (it + step < (I_)) p0_item_load(Wp, N_, it + step, lane, a1); } \
        while (ha) { \
            const int itb = it + 2 * step; const bool hb = itb < (I_); \
            if (hb) { p0_item_load(Wp, N_, itb, lane, b0); if (itb + step < (I_)) p0_item_load(Wp, N_, itb + step, lane, b1); } \
            p0_item_body<FOLD_>(a0, K_, N_, WTp, scr, it, lane, false, G_, B_, U_, C_); \
            if (it + step < (I_)) p0_item_body<FOLD_>(a1, K_, N_, WTp, scr, it + step, lane, false, G_, B_, U_, C_); \
            if (!hb) break; \
            const int ita = itb + 2 * step; ha = ita < (I_); \
            if (ha) { p0_item_load(Wp, N_, ita, lane, a0); if (ita + step < (I_)) p0_item_load(Wp, N_, ita + step, lane, a1); } \
            p0_item_body<FOLD_>(b0, K_, N_, WTp, scr, itb, lane, false, G_, B_, U_, C_); \
            if (itb + step < (I_)) p0_item_body<FOLD_>(b1, K_, N_, WTp, scr, itb + step, lane, false, G_, B_, U_, C_); \
            it = ita; } } while (0)
    DEF_MATRIX(false, A.w_out, DM, DM, A.woT, I_O, nullptr, nullptr, nullptr, nullptr);
    DEF_MATRIX(true, A.w1, DM, DFF, A.w1T, I_1, A.ln1_g, A.ln1_b, A.uvec, A.cvec);
    DEF_MATRIX(false, A.w2, DFF, DM, A.w2T, I_2, nullptr, nullptr, nullptr, nullptr);
#undef DEF_MATRIX
}

#define RET_TRRD(dst, base, off) asm volatile("ds_read_b64_tr_b16 %0, %1 offset:%2" : "=&v"(dst) : "v"(base), "i"(off) : "memory")
__device__ __forceinline__ float gamma_of(int h) { return 1.0f - exp2f(-5.0f - (float)h); }
__device__ __forceinline__ float pow_2k(float g, int k) { for (int i = 0; i < k; ++i) g = g * g; return g; }
__device__ __forceinline__ void ret_r1_chunk(Frame& F, const bf16* proj, bf16* sst, int u) {
    const int bh = u >> 6, n = u & 63, b = bh >> 3, h = bh & 7;
    int tid_ = F.tid; asm volatile("" : "+v"(tid_));
    const int tid = tid_, lane = tid & 63, wid = __builtin_amdgcn_readfirstlane(tid >> 6), r32 = lane & 31, hi = lane >> 5;
    const bf16* rowbase = proj + (size_t)(b * SEQ + n * 128) * NPROJ;
    unsigned char* lds = (unsigned char*)F.lds;
    {
        bf16x8 kv[4], vv[8];
#pragma unroll
        for (int j = 0; j < 4; ++j) { const int m = (tid >> 4) + 32 * j; kv[j] = *(const bf16x8*)(rowbase + (size_t)m * NPROJ + C_RK + h * 128 + (tid & 15) * 8); }
#pragma unroll
        for (int j = 0; j < 8; ++j) { const int m = (tid >> 5) + 16 * j; vv[j] = *(const bf16x8*)(rowbase + (size_t)m * NPROJ + C_RV + h * 256 + (tid & 31) * 8); }
#pragma unroll
        for (int j = 0; j < 4; ++j) { const int m = (tid >> 4) + 32 * j; *(bf16x8*)(lds + (m >> 6) * 16384 + att::v_st(m & 63, (tid & 15) * 8)) = kv[j]; }
#pragma unroll
        for (int j = 0; j < 8; ++j) { const int m = (tid >> 5) + 16 * j, e = (tid & 31) * 8; *(bf16x8*)(lds + 32768 + ((m >> 6) * 2 + (e >> 7)) * 16384 + att::v_st(m & 63, e & 127)) = vv[j]; }
    }
    __syncthreads();
    const int ib = wid & 3, eh = wid >> 2;
    f32x16 acc[4] = {};
    const int rb = att::v_rd_base(lane);
#pragma unroll
    for (int t = 0; t < 2; ++t) {
        const int kbase = (int)(uintptr_t)lds + t * 16384 + rb + ib * 512;
        const int vbase = (int)(uintptr_t)lds + 32768 + (t * 2 + eh) * 16384 + rb;
#pragma unroll
        for (int ks = 0; ks < 4; ++ks) {
            s16x4 al, ah, bl[4], bh_[4];
            RET_TRRD(al, kbase, ks * 4096); RET_TRRD(ah, kbase, ks * 4096 + 2048);
#pragma unroll
            for (int d0 = 0; d0 < 4; ++d0) { RET_TRRD(bl[d0], vbase, d0 * 512 + ks * 4096); RET_TRRD(bh_[d0], vbase, d0 * 512 + ks * 4096 + 2048); }
            asm volatile("s_waitcnt lgkmcnt(0)" ::: "memory"); __builtin_amdgcn_sched_barrier(0);
            const bf16x8 a = (bf16x8){al[0], al[1], al[2], al[3], ah[0], ah[1], ah[2], ah[3]};
#pragma unroll
            for (int d0 = 0; d0 < 4; ++d0) acc[d0] = __builtin_amdgcn_mfma_f32_32x32x16_bf16(a, (bf16x8){bl[d0][0], bl[d0][1], bl[d0][2], bl[d0][3], bh_[d0][0], bh_[d0][1], bh_[d0][2], bh_[d0][3]}, acc[d0], 0, 0, 0);
        }
    }
    const float g = gamma_of(h); float g127 = 1.f; { float p = g; for (int i = 0; i < 7; ++i) { g127 *= p; p = p * p; } }
    bf16* So = sst + ((size_t)(bh * 64 + n) * 128) * 256 + (size_t)(ib * 32 + 4 * hi) * 256 + eh * 128 + r32;
#pragma unroll
    for (int r = 0; r < 16; ++r) { const int dc = (r & 3) + 8 * (r >> 2);
#pragma unroll
        for (int d0 = 0; d0 < 4; ++d0) { const float y = acc[d0][r] * g127; const float yn = __shfl_xor(y, 1);
            if ((r32 & 1) == 0) *(unsigned*)(So + (size_t)dc * 256 + d0 * 32) = pk2(y, yn); } }
    __syncthreads();
}
__device__ __forceinline__ void ret_r2_scan(Frame& F, const bf16* sst, bf16* rg, unsigned* done_cnt) {
    const int nvec = 16 * 8192;
    for (int idx = F.vcu * 512 + F.tid; idx < nvec; idx += F.G * 512) {
        const int bh = idx >> 13, e4 = idx & 8191, h = bh & 7;
        const float g = gamma_of(h), gC = pow_2k(g, 7);
        const GAS v2u* sp = (const GAS v2u*)sst + (size_t)bh * 64 * 8192 + e4;
        unsigned long long* rp = (unsigned long long*)rg + (size_t)bh * 64 * 8192 + e4;
        f32x4 r = {0.f, 0.f, 0.f, 0.f};
        for (int n0 = 0; n0 < 64; n0 += 8) {
            v2u sv[8];
#pragma unroll
            for (int j = 0; j < 8; ++j) sv[j] = sp[(size_t)(n0 + j) * 8192];
#pragma unroll
            for (int j = 0; j < 8; ++j) { const f32x4 o = r * g; const unsigned long long w = (unsigned long long)pk2(o.x, o.y) | ((unsigned long long)pk2(o.z, o.w) << 32);
                __hip_atomic_store(rp + (size_t)(n0 + j) * 8192, w, __ATOMIC_RELAXED, __HIP_MEMORY_SCOPE_AGENT);
                const f32x4 sj = {__uint_as_float(sv[j].x << 16), __uint_as_float(sv[j].x & 0xffff0000u), __uint_as_float(sv[j].y << 16), __uint_as_float(sv[j].y & 0xffff0000u)};
                r = r * gC + sj; }
        }
    }
    VM_WAIT();
    if (F.lane == 0) __hip_atomic_fetch_add(done_cnt, 1u, __ATOMIC_RELAXED, __HIP_MEMORY_SCOPE_AGENT);
}
__device__ __forceinline__ void ret_r3_chunk(Frame& F, const bf16* proj, const bf16* rg, const float* gn_g, bf16* mix, int u) {
    const int bh = u >> 6, n = u & 63, b = bh >> 3, h = bh & 7;
    int tid_ = F.tid; asm volatile("" : "+v"(tid_));
    const int tid = tid_, lane = tid & 63, wid = __builtin_amdgcn_readfirstlane(tid >> 6), r32 = lane & 31, hi = lane >> 5;
    const size_t row0 = (size_t)(b * SEQ + n * 128);
    const bf16* rowbase = proj + row0 * NPROJ;
    const bf16* rgb = rg + (size_t)(bh * 64 + n) * 128 * 256;
    unsigned char* lds = (unsigned char*)F.lds;
    const int qb4 = wid & 3, eq = wid >> 2;
    bf16x8 qr[8];
#pragma unroll
    for (int d0 = 0; d0 < 8; ++d0) qr[d0] = *(const bf16x8*)(rowbase + (size_t)(qb4 * 32 + r32) * NPROJ + C_RQ + h * 128 + d0 * 16 + hi * 8);
#define R3_STAGE_K() do { bf16x8 kv[4]; _Pragma("unroll") for (int j = 0; j < 4; ++j) { const int m = (tid >> 4) + 32 * j; kv[j] = *(const bf16x8*)(rowbase + (size_t)m * NPROJ + C_RK + h * 128 + (tid & 15) * 8); } \
        _Pragma("unroll") for (int j = 0; j < 4; ++j) { const int m = (tid >> 4) + 32 * j; *(bf16x8*)(lds + (m >> 6) * 16384 + KSWZ(m & 63, (tid & 15) * 16)) = kv[j]; } } while (0)
#define R3_STAGE_VR(half) do { bf16x8 vv[4], rr[4]; _Pragma("unroll") for (int j = 0; j < 4; ++j) { const int m = (tid >> 4) + 32 * j; \
            vv[j] = *(const bf16x8*)(rowbase + (size_t)m * NPROJ + C_RV + h * 256 + (half) * 128 + (tid & 15) * 8); rr[j] = *(const bf16x8*)(rgb + (size_t)m * 256 + (half) * 128 + (tid & 15) * 8); } \
        _Pragma("unroll") for (int j = 0; j < 4; ++j) { const int m = (tid >> 4) + 32 * j; const int o_ = (m >> 6) * 16384 + att::v_st(m & 63, (tid & 15) * 8); *(bf16x8*)(lds + 32768 + o_) = vv[j]; *(bf16x8*)(lds + 65536 + o_) = rr[j]; } } while (0)
    R3_STAGE_K(); R3_STAGE_VR(0);
    __syncthreads();
    bf16x8 pa[8];
#pragma unroll
    for (int kt = 0; kt < 2; ++kt) {
        f32x16 p0 = {}, p1 = {};
        const unsigned char* kbp = lds + kt * 16384;
#pragma unroll
        for (int d0 = 0; d0 < 8; ++d0) { const unsigned char* a = kbp + KSWZ(r32, ((d0 & 3) * 16 + hi * 8) * 2) + (d0 >> 2) * 128;
            const bf16x8 b0 = *(const bf16x8*)a, b1 = *(const bf16x8*)(a + 32 * 256);
            p0 = __builtin_amdgcn_mfma_f32_32x32x16_bf16(b0, qr[d0], p0, 0, 0, 0);
            p1 = __builtin_amdgcn_mfma_f32_32x32x16_bf16(b1, qr[d0], p1, 0, 0, 0); }
        const int dq = qb4 * 32 + r32 - 64 * kt - 4 * hi;
#pragma unroll
        for (int r = 0; r < 16; ++r) { const int c = (r & 3) + 8 * (r >> 2); if (dq - c < 0) p0[r] = 0.f; if (dq - c - 32 < 0) p1[r] = 0.f; }
        ATT_PK4(p0, 0, pa[kt * 4 + 0]); ATT_PK4(p0, 8, pa[kt * 4 + 1]); ATT_PK4(p1, 0, pa[kt * 4 + 2]); ATT_PK4(p1, 8, pa[kt * 4 + 3]);
    }
    f32x16 o[2][2] = {};
    const int rb = (int)(uintptr_t)lds + att::v_rd_base(lane);
#define R3_ACC(half) do { _Pragma("unroll") for (int d0 = 0; d0 < 2; ++d0) { const int cb = (eq * 2 + d0) * 512; \
        _Pragma("unroll") for (int kt = 0; kt < 2; ++kt) { const int vb_ = rb + 32768 + kt * 16384 + cb, rb_ = rb + 65536 + kt * 16384 + cb; \
            _Pragma("unroll") for (int ks = 0; ks < 4; ++ks) { s16x4 vl, vh, rl, rh; \
                RET_TRRD(vl, vb_, ks * 4096); RET_TRRD(vh, vb_, ks * 4096 + 2048); RET_TRRD(rl, rb_, ks * 4096); RET_TRRD(rh, rb_, ks * 4096 + 2048); \
                asm volatile("s_waitcnt lgkmcnt(0)" ::: "memory"); __builtin_amdgcn_sched_barrier(0); \
                o[half][d0] = __builtin_amdgcn_mfma_f32_32x32x16_bf16(pa[kt * 4 + ks], (bf16x8){vl[0], vl[1], vl[2], vl[3], vh[0], vh[1], vh[2], vh[3]}, o[half][d0], 0, 0, 0); \
                o[half][d0] = __builtin_amdgcn_mfma_f32_32x32x16_bf16(qr[kt * 4 + ks], (bf16x8){rl[0], rl[1], rl[2], rl[3], rh[0], rh[1], rh[2], rh[3]}, o[half][d0], 0, 0, 0); } } } } while (0)
    R3_ACC(0);
    __syncthreads();
    R3_STAGE_VR(1);
    bf16x8 gq[8];
#pragma unroll
    for (int j = 0; j < 8; ++j) gq[j] = *(const bf16x8*)(rowbase + (size_t)((tid >> 5) + 16 * j) * NPROJ + C_RG + h * 256 + (tid & 31) * 8);
    __syncthreads();
    R3_ACC(1);
    LAS float* st = (LAS float*)(F.lds + 98304);
    LAS float* st_own = st + (wid * 32 + 4 * hi) * 2; LAS float* st_oth = st + ((wid ^ 4) * 32 + 4 * hi) * 2;
    {
        float s1[16], s2[16];
#pragma unroll
        for (int r = 0; r < 16; ++r) { const float a = o[0][0][r], b2 = o[0][1][r], c2 = o[1][0][r], d2 = o[1][1][r]; s1[r] = (a + b2) + (c2 + d2); s2[r] = (a * a + b2 * b2) + (c2 * c2 + d2 * d2); }
#pragma unroll
        for (int sft = 1; sft < 32; sft <<= 1)
#pragma unroll
            for (int r = 0; r < 16; ++r) { s1[r] += __shfl_xor(s1[r], sft); s2[r] += __shfl_xor(s2[r], sft); }
        if (r32 == 0) {
#pragma unroll
            for (int r = 0; r < 16; ++r) { const int c8 = ((r & 3) + 8 * (r >> 2)) * 2; st_own[c8] = s1[r]; st_own[c8 + 1] = s2[r]; }
        }
    }
    __syncthreads();
    constexpr int GST = 528;
#pragma unroll
    for (int j = 0; j < 8; ++j) *(bf16x8*)(lds + ((tid >> 5) + 16 * j) * GST + (tid & 31) * 16) = gq[j];
    __syncthreads();
    const float* gnp = gn_g + h * 256;
    const unsigned char* gl = lds + (qb4 * 32 + 4 * hi) * GST + (eq * 64 + r32) * 2;
    bf16* mp = mix + row0 * DM + 2048 + h * 256 + (size_t)(qb4 * 32 + 4 * hi) * DM + eq * 64 + r32;
    float gn[4];
#pragma unroll
    for (int q = 0; q < 4; ++q) gn[q] = gnp[(q >> 1) * 128 + eq * 64 + (q & 1) * 32 + r32];
#pragma unroll
    for (int r = 0; r < 16; ++r) { const int rc = (r & 3) + 8 * (r >> 2);
        const int c8 = ((r & 3) + 8 * (r >> 2)) * 2;
        const float t1 = st_own[c8] + st_oth[c8], t2 = st_own[c8 + 1] + st_oth[c8 + 1];
        const float mean = t1 * (1.0f / 256.0f), var = fmaxf(t2 * (1.0f / 256.0f) - mean * mean, 0.f), rstd = 1.0f / sqrtf(var + LN_EPS);
#pragma unroll
        for (int half = 0; half < 2; ++half)
#pragma unroll
            for (int d0 = 0; d0 < 2; ++d0) { const int e = half * 128 + d0 * 32;
                const float gate = bf2f(*(const unsigned short*)(gl + rc * GST + e * 2)); const float sg = gate / (1.0f + __expf(-gate));
                const float y = (o[half][d0][r] - mean) * rstd * gn[half * 2 + d0] * sg;
                const float yn = __shfl_xor(y, 1);
                if ((r32 & 1) == 0) *(unsigned*)(mp + (size_t)rc * DM + e) = pk2(y, yn); } }
    __syncthreads();
#undef R3_STAGE_K
#undef R3_STAGE_VR
#undef R3_ACC
}

__device__ __forceinline__ void ln2_apply(Frame& F, const bf16* pre2, const float* stats2, const float* gain, const float* bias, float* out) {
    const int gw = F.vcu * NWAVES + F.wave, NGW = F.G * NWAVES;
    f32x4 g[8][2], bb[8][2];
    { const GAS f32x4* gr = (const GAS f32x4*)gain + 2 * F.lane; const GAS f32x4* br = (const GAS f32x4*)bias + 2 * F.lane;
#pragma unroll
      for (int j = 0; j < 8; ++j) { g[j][0] = gr[128 * j]; g[j][1] = gr[128 * j + 1]; bb[j][0] = br[128 * j]; bb[j][1] = br[128 * j + 1]; } }
    for (int m = gw; m < M; m += NGW) {
        const float s1 = stats2[2 * m], s2 = stats2[2 * m + 1];
        const float mu = s1 * (1.f / DM), rs = 1.f / sqrtf(fmaxf(s2 * (1.f / DM) - mu * mu, 0.f) + LN_EPS);
        const GAS v4u* pr = (const GAS v4u*)(pre2 + (size_t)m * DM) + F.lane;
        v4u w[8];
#pragma unroll
        for (int j = 0; j < 8; ++j) w[j] = pr[64 * j];
        GAS f32x4* orow = (GAS f32x4*)(out + (size_t)m * DM) + 2 * F.lane;
#pragma unroll
        for (int j = 0; j < 8; ++j) {
            f32x4 p0, p1;
            p0[0] = __uint_as_float(w[j].x << 16); p0[1] = __uint_as_float(w[j].x & 0xffff0000u); p0[2] = __uint_as_float(w[j].y << 16); p0[3] = __uint_as_float(w[j].y & 0xffff0000u);
            p1[0] = __uint_as_float(w[j].z << 16); p1[1] = __uint_as_float(w[j].z & 0xffff0000u); p1[2] = __uint_as_float(w[j].w << 16); p1[3] = __uint_as_float(w[j].w & 0xffff0000u);
            orow[128 * j] = ((p0 - mu) * rs) * g[j][0] + bb[j][0]; orow[128 * j + 1] = ((p1 - mu) * rs) * g[j][1] + bb[j][1]; }
    }
}

struct Args { const float* in[13]; float* out; unsigned char* ws; int ph_lo, ph_hi; };
__global__ void __launch_bounds__(NWAVES * 64, 2) mega_fwd(Args args) {
    extern __shared__ __attribute__((aligned(16))) unsigned char lds[];
    Frame F;
    F.lds = (LAS unsigned char*)lds;
    F.MISC = (volatile LAS unsigned*)(F.lds + MISC_OFF);
    F.tid = threadIdx.x; F.lane = F.tid & 63; F.wave = __builtin_amdgcn_readfirstlane(F.tid >> 6);
    F.G = gridDim.x; { const int bx = blockIdx.x; F.vcu = (F.G % 8 == 0) ? (bx % 8) * (F.G / 8) + bx / 8 : bx; }
    unsigned char* ws = args.ws;
    F.ctl = (gu32*)(ws + WS_CTL);
    for (int u = F.tid; u < (LDS_BYTES - LDSCTL_OFF) / 4; u += NWAVES * 64) ((LAS unsigned*)(F.lds + LDSCTL_OFF))[u] = 0u;
    __syncthreads();
    XcdBarrier bar; bar.bar = (unsigned*)(F.ctl + CW_BAR); bar.x = 0; bar.st = nullptr;
    if (N_LAUNCHES == 1) bar = xcd_barrier_post((unsigned*)(F.ctl + CW_BAR), F.MISC + 8, F.tid == 0);
#define GRID_BAR() do { if (N_LAUNCHES == 1) { refresh_ids(F); xcd_barrier(bar, F.tid == 0); } } while (0)
    const int lo = args.ph_lo, hi = args.ph_hi;
#ifndef MK_PHMASK
#define MK_PHMASK 0x3ff
#endif
#define IN(k) (((MK_PHMASK >> (k)) & 1) && lo <= (k) && (k) < hi)
#define BOTH(k) (IN(k) && IN((k) + 1))
#ifndef MK_REPEAT
#define MK_REPEAT 0
#endif
#define REPS(k) (((MK_REPEAT >> (k)) & 1) ? 2 : 1)
    const float* x = args.in[0]; const float* w_in = args.in[1]; const float* att_lambda = args.in[2]; const float* att_subln_g = args.in[3]; const float* ret_gn_g = args.in[4];
    const float* w_out = args.in[5]; const float* ln1_g = args.in[6]; const float* ln1_b = args.in[7]; const float* w_ff1 = args.in[8]; const float* w_ff2 = args.in[9];
    const float* ln2_g = args.in[10]; const float* ln2_b = args.in[11]; const float* rel_bias = args.in[12];
    float* out = args.out;
    bf16* xb = (bf16*)(ws + WS_XB); bf16* mixb = (bf16*)(ws + WS_MIX); bf16* pre1b = (bf16*)(ws + WS_PRE1);
    float* stats2 = (float*)(ws + WS_STATS2); bf16* pre2b = (bf16*)(ws + WS_PRE2);
    float* stats = (float*)(ws + WS_STATS); float* uvec = (float*)(ws + WS_UVEC); float* cvec = (float*)(ws + WS_CVEC);
    bf16* winT = (bf16*)(ws + WS_WINT); bf16* woT = (bf16*)(ws + WS_WOT); bf16* w1T = (bf16*)(ws + WS_W1T); bf16* w2T = (bf16*)(ws + WS_W2T);
    bf16* proj = (bf16*)(ws + WS_PROJ); bf16* hb = (bf16*)(ws + WS_H);
    float* rope = (float*)(ws + WS_ROPE); float* dec = (float*)(ws + WS_DEC);
    bf16* sst = (bf16*)(ws + WS_SST); float* ascr = (float*)(ws + WS_ASCR); bf16* rgb = (bf16*)(ws + WS_RG);

    refresh_ids(F);
    if (IN(0)) { P0Args A{x, w_in, w_out, w_ff1, w_ff2, ln1_g, ln1_b, xb, winT, woT, w1T, w2T, rope, dec, uvec, cvec, (unsigned*)(ws + WS_QUEUE)}; _Pragma("unroll") for (int rep = 0; rep < REPS(0); ++rep) p0_prologue(F, A); if (BOTH(0)) GRID_BAR(); }

    refresh_ids(F);
    if (IN(1))
#pragma unroll
    for (int rep = 0; rep < REPS(1); ++rep) {
        pg8::Gemm g{xb, winT, M, NPROJ, DM}; pg8::StaticOrder S0; S0.init(M, NPROJ, F.G, (int)blockIdx.x);
        pg8::EpiProj E{proj, rope, dec};
        P0Args A{x, w_in, w_out, w_ff1, w_ff2, ln1_g, ln1_b, xb, winT, woT, w1T, w2T, rope, dec, uvec, cvec, (unsigned*)(ws + WS_QUEUE)};
        const int ksplit = 2 + ((int)blockIdx.x & 7);
#pragma unroll 1
        for (int part = 0; part < 2; ++part) {
            pg8::RangeOrder S{S0, part == 0 ? 0 : ksplit, part == 0 ? ksplit : (1 << 30)};
            pg8::gemm_phase<pg8::EpiProj, pg8::RangeOrder, true, true>(F.lds + RING_OFF, g, S, E, F.wave);
            if (part == 0) { refresh_ids(F); p0_deferred(F, A); __syncthreads(); }
        }
        if (BOTH(1) && rep == REPS(1) - 1) GRID_BAR();
    }

    refresh_ids(F);
    if (IN(2)) { for (int uu = F.vcu; uu < 1024; uu += F.G) ret_r1_chunk(F, proj, sst, uu); if (BOTH(2)) GRID_BAR(); }

    refresh_ids(F);
    if (IN(3)) {
        unsigned* scan_cnt = (unsigned*)(ws + WS_QUEUE) + 64; unsigned* r3_head = (unsigned*)(ws + WS_QUEUE) + 128;
        ret_r2_scan(F, sst, rgb, scan_cnt);
        refresh_ids(F);
        float lam;
        { const float a = att_lambda[F.lane] * att_lambda[128 + F.lane] + att_lambda[64 + F.lane] * att_lambda[192 + F.lane];
          const float b2 = att_lambda[256 + F.lane] * att_lambda[384 + F.lane] + att_lambda[320 + F.lane] * att_lambda[448 + F.lane];
          lam = expf(wave_sum(a)) - expf(wave_sum(b2)) + LAMBDA_INIT; }
        char* alds = (char*)lds + RING_OFF; att::lds_ptr aldsa = (att::lds_ptr)(F.lds + RING_OFF);
        float* myscr = ascr + (size_t)blockIdx.x * (256 * 256);
        for (int uu = F.vcu; uu < 256; uu += F.G) {
            const int u = uu & 255, bh = u >> 4, xq = u & 15, b = bh >> 3, h = bh & 7;
            { float* T = (float*)(alds + att::OFF_BIAS); const float far = rel_bias[31 * 8 + h];
              refresh_ids(F);
              for (int i = F.tid; i < 384; i += NWAVES * 64) { const int dist = i - 128, nn = dist < 0 ? 0 : dist;
                  T[i] = nn >= 128 ? 0.f : (rel_bias[(int)T5_BUCKET[nn] * 8 + h] - far) * LOG2E; } }
            __syncthreads();
            const bf16* pb = proj + (size_t)b * SEQ * NPROJ;
            for (int i = 0; i < 4; ++i) {
                const int qb_ = i < 2 ? xq : 31 - xq, m_ = i & 1;
                att::BlockRef R;
                R.Q = pb + (size_t)qb_ * 256 * NPROJ + C_AQ + h * 256 + m_ * 128; R.K = pb + C_AK + h * 256 + m_ * 128; R.V = pb + C_AV + h * 256;
                R.O = myscr; R.mixrow = mixb + ((size_t)b * SEQ + qb_ * 256) * DM + h * 256; R.P0 = qb_ * 256; R.m = m_;
                att::block(R, aldsa, lam, att_subln_g, 1.0f - LAMBDA_INIT, F.wave);
            }
        }
        refresh_ids(F);
        if (F.wave == 0) {
            const unsigned want = (unsigned)F.G * NWAVES; unsigned sp_ = 0;
            while (__hip_atomic_load(scan_cnt, RLX_AGENT) < want) { __builtin_amdgcn_s_sleep(2); if (++sp_ > (1u << 22)) { if (F.lane == 0) atomicAdd((unsigned*)(F.ctl + CW_BAR) + XB_TMO, 1u); break; } }
            __builtin_amdgcn_fence(__ATOMIC_ACQUIRE, "agent");
            VM_WAIT();
        }
        __syncthreads();
        {
            volatile LAS unsigned* cslot = F.MISC + 20;
            unsigned nxt = 0;
            if (F.tid == 0) nxt = __hip_atomic_fetch_add(r3_head, 1u, __ATOMIC_RELAXED, __HIP_MEMORY_SCOPE_AGENT);
            for (int rnd = 0;; ++rnd) {
                refresh_ids(F);
                if (F.tid == 0) { cslot[rnd & 1] = nxt; nxt = __hip_atomic_fetch_add(r3_head, 1u, __ATOMIC_RELAXED, __HIP_MEMORY_SCOPE_AGENT); }
                __syncthreads();
                const unsigned uq = cslot[rnd & 1];
                if (uq >= 1024u) break;
                ret_r3_chunk(F, proj, rgb, ret_gn_g, mixb, (int)uq);
            }
        }
        if (BOTH(3)) GRID_BAR();
    }

    refresh_ids(F);
    if (IN(4))
#pragma unroll
    for (int rep = 0; rep < REPS(4); ++rep) {
        pg8::Gemm g{mixb, woT, M, DM, DM}; pg8::StaticOrder S; S.init(M, DM, F.G, (int)blockIdx.x);
        pg8::EpiPre1 E{x, pre1b, stats, DM, ALPHA};
        pg8::gemm_phase<pg8::EpiPre1, pg8::StaticOrder, true, true>(F.lds + RING_OFF, g, S, E, F.wave);
        if (BOTH(4) && rep == REPS(4) - 1) GRID_BAR();
    }

    refresh_ids(F);
    if (IN(5))
#pragma unroll
    for (int rep = 0; rep < REPS(5); ++rep) {
        pg8::Gemm g{pre1b, w1T, M, DFF, DM}; pg8::StaticOrder S; S.init(M, DFF, F.G, (int)blockIdx.x);
        pg8::EpiSqReluLn E{hb, DFF, stats, uvec, cvec, 1.0f / DM, LN_EPS};
        pg8::gemm_phase<pg8::EpiSqReluLn, pg8::StaticOrder, true, true>(F.lds + RING_OFF, g, S, E, F.wave);
        if (BOTH(5) && rep == REPS(5) - 1) GRID_BAR();
    }

    refresh_ids(F);
    if (IN(6))
#pragma unroll
    for (int rep = 0; rep < REPS(6); ++rep) {
        pg8::Gemm g{hb, w2T, M, DM, DFF}; pg8::StaticOrder S; S.init(M, DM, F.G, (int)blockIdx.x);
        pg8::EpiResidLn E{pre1b, pre2b, stats2, DM, stats, ln1_g, ln1_b, ALPHA, 1.0f / DM, LN_EPS};
        pg8::gemm_phase<pg8::EpiResidLn, pg8::StaticOrder, true, true>(F.lds + RING_OFF, g, S, E, F.wave);
        if (BOTH(6) && rep == REPS(6) - 1) GRID_BAR();
    }

    refresh_ids(F);
    if (IN(7)) {
        ln2_apply(F, pre2b, stats2, ln2_g, ln2_b, out);
        if (N_LAUNCHES == 1) { VM_WAIT(); __syncthreads();
            if (__hip_atomic_load((unsigned*)(F.ctl + CW_BAR) + XB_TMO, RLX_AGENT) != 0u) { const int gw = F.vcu * NWAVES + F.wave, NGW = F.G * NWAVES; const float q = __builtin_nanf("");
                for (int m = gw; m < M; m += NGW) { GAS f32x4* o = (GAS f32x4*)(out + (size_t)m * DM) + F.lane; for (int j = 0; j < 16; ++j) o[64 * j] = (f32x4){q, q, q, q}; } } }
    }
#undef IN
#undef BOTH
#undef GRID_BAR
}

extern "C" void kernel_launch(void* const* d_in, const int* in_sizes, int n_in, void* d_out, int out_size, void* d_ws, size_t ws_size, hipStream_t stream) {
    static int grid = 0;
    if (grid == 0) {
        if (n_in != 13 || in_sizes[0] != M * DM || out_size != M * DM || ws_size < WS_END) { fprintf(stderr, "kernel_launch: unexpected shapes (n_in %d, in0 %d, out %d, ws %zu); nothing launched\n", n_in, n_in > 0 ? in_sizes[0] : -1, out_size, ws_size); grid = -1; return; }
        int dev = 0, cus = 0, per_cu = 0;
        if (hipGetDevice(&dev) != hipSuccess || hipDeviceGetAttribute(&cus, hipDeviceAttributeMultiprocessorCount, dev) != hipSuccess) { fprintf(stderr, "kernel_launch: device query failed\n"); grid = -1; return; }
        if (hipFuncSetAttribute((const void*)mega_fwd, hipFuncAttributeMaxDynamicSharedMemorySize, LDS_BYTES) != hipSuccess) { fprintf(stderr, "kernel_launch: hipFuncSetAttribute failed\n"); grid = -1; return; }
        if (hipOccupancyMaxActiveBlocksPerMultiprocessor(&per_cu, (const void*)mega_fwd, NWAVES * 64, LDS_BYTES) != hipSuccess || per_cu < 1) fprintf(stderr, "kernel_launch: occupancy query reports %d\n", per_cu);
        (void)hipGetLastError();
        grid = cus;
    }
    if (grid < 0) return;
    if (hipMemsetAsync((char*)d_ws + WS_CTL, 0, CTL_ZERO_BYTES, stream) != hipSuccess) { fprintf(stderr, "kernel_launch: memset failed\n"); return; }
    Args a{};
    for (int i = 0; i < 13; ++i) a.in[i] = (const float*)d_in[i];
    a.out = (float*)d_out; a.ws = (unsigned char*)d_ws;
    for (int li = 0; li < N_LAUNCHES; ++li) {
        a.ph_lo = (N_LAUNCHES == 1) ? 0 : li; a.ph_hi = (N_LAUNCHES == 1) ? N_PHASES : li + 1;
        hipLaunchKernelGGL(mega_fwd, dim3(grid), dim3(NWAVES * 64), LDS_BYTES, stream, a);
        const hipError_t le = hipPeekAtLastError();
        if (le != hipSuccess) { fprintf(stderr, "kernel_launch: launch %d failed: %s\n", li, hipGetErrorName(le)); break; }
    }
}
```

```cpp
#include <hip/hip_runtime.h>
#include <cstdio>
#include <cstdint>
#include <cmath>
namespace pg8 {
#define PG8_LAS __attribute__((address_space(3)))
typedef unsigned short bf16_t;
typedef short bf16x8 __attribute__((ext_vector_type(8)));
typedef float f32x4 __attribute__((ext_vector_type(4)));
typedef unsigned u32x4 __attribute__((ext_vector_type(4)));
constexpr int BM = 256, BK = 64, HALF = 128, HTB = HALF * BK * 2  , STAGE_BYTES = 8 * HTB, NXCD = 8, WGM = 8;

__host__ __device__ __forceinline__ int lds_byte(int r, int c) { const int st = (r >> 4) * 2 + (c >> 5), rr = r & 15, cc = c & 31, ob = rr * 64 + cc * 2; return st * 1024 + (ob ^ (((ob >> 9) & 1) << 5)); }
__host__ __device__ __forceinline__ void stage_rc(int b, int& R, int& C) { const int st = b / 1024, sb = b % 1024, swz = sb ^ (((sb >> 9) & 1) << 5); R = (st >> 1) * 16 + swz / 64; C = (st & 1) * 32 + (swz % 64) / 2; }
__host__ __device__ __forceinline__ int perm32(int rho) { const int n = rho >> 4, i = rho & 15; return 8 * (i >> 2) + 4 * n + (i & 3); }

struct Unit { int pm, pn; };
struct Gemm { const bf16_t* A; const bf16_t* Bt; int M, N, K; };

struct StaticOrder {
    int nM, nN, nwg, G, c;
    __host__ __device__ void init(int M, int N, int G_, int c_) { nM = M / BM; nN = N / BM; nwg = nM * nN; G = G_; c = c_; }
    __host__ __device__ bool next(int i, Unit& u) const {
        const long L = (long)i * G + c; if (L >= nwg) return false;
        int wgid = (int)L; { const int q = nwg / NXCD, r = nwg % NXCD, xcd = wgid % NXCD, off = wgid / NXCD; wgid = (xcd < r ? xcd * (q + 1) : r * (q + 1) + (xcd - r) * q) + off; }
        const int nig = WGM * nN, gid = wgid / nig, fm = gid * WGM, gsz = (nM - fm) < WGM ? (nM - fm) : WGM;
        u.pm = fm + ((wgid % nig) % gsz); u.pn = (wgid % nig) / gsz; return true;
    }
    __device__ __forceinline__ void a_ready(const Unit&) const {}
    __device__ __forceinline__ void done(const Unit&) const {}
};

__device__ __forceinline__ unsigned cvt_pk_bf16(float lo, float hi) { unsigned r; asm volatile("v_cvt_pk_bf16_f32 %0, %1, %2" : "=v"(r) : "v"(lo), "v"(hi)); return r; }
typedef float f32x2 __attribute__((ext_vector_type(2)));
constexpr int NPROJ = 12288;
constexpr float QSCALE = 0.08838834764831845f * 1.4426950408889634f;
struct EpiProj {
    static constexpr bool PERM = true, AFTER_DRAIN = false;
    bf16_t* O; const float* rope; const float* dec;
    __device__ __forceinline__ void operator()(const f32x4 (&acc)[2][2][4][2], const Unit& u, int wr, int wc, int fr, int fq) const {
        const int row0 = u.pm * BM + wr * 64 + fr, col0 = u.pn * BM + wc * 32 + 8 * fq, pn = u.pn;
        if (pn >= 24 && pn < 32) {
            const int isk = pn >= 28 ? 1 : 0, hb = 2 * (pn - (isk ? 28 : 24)), i0 = 16 * wc + 4 * fq;
#pragma unroll
            for (int ai = 0; ai < 2; ++ai)
#pragma unroll
                for (int m = 0; m < 4; ++m) {
                    const int row = row0 + ai * HALF + m * 16, pos = row & 8191, cc = pos & 127;
                    const f32x4 cs0 = *(const f32x4*)(rope + ((size_t)pos * 64 + i0) * 2), cs1 = *(const f32x4*)(rope + ((size_t)pos * 64 + i0) * 2 + 4);
                    bf16_t* rowp = O + (size_t)row * NPROJ + col0;
#pragma unroll
                    for (int bj = 0; bj < 2; ++bj) {
                        const float d = dec[((hb + bj) * 128 + cc) * 2 + isk];
                        const f32x4 v0 = acc[ai][bj][m][0], v1 = acc[ai][bj][m][1];
                        const float a0 = (v0[0] * cs0[0] - v0[1] * cs0[1]) * d, a1 = (v0[1] * cs0[0] + v0[0] * cs0[1]) * d;
                        const float a2 = (v0[2] * cs0[2] - v0[3] * cs0[3]) * d, a3 = (v0[3] * cs0[2] + v0[2] * cs0[3]) * d;
                        const float a4 = (v1[0] * cs1[0] - v1[1] * cs1[1]) * d, a5 = (v1[1] * cs1[0] + v1[0] * cs1[1]) * d;
                        const float a6 = (v1[2] * cs1[2] - v1[3] * cs1[3]) * d, a7 = (v1[3] * cs1[2] + v1[2] * cs1[3]) * d;
                        u32x4 w; w.x = cvt_pk_bf16(a0, a1); w.y = cvt_pk_bf16(a2, a3); w.z = cvt_pk_bf16(a4, a5); w.w = cvt_pk_bf16(a6, a7);
                        *(u32x4*)(rowp + bj * HALF) = w;
                    }
                }
        } else {
            const float sc = pn < 8 ? QSCALE : 1.0f;
#pragma unroll
            for (int ai = 0; ai < 2; ++ai)
#pragma unroll
                for (int m = 0; m < 4; ++m) { bf16_t* rowp = O + (size_t)(row0 + ai * HALF + m * 16) * NPROJ + col0;
#pragma unroll
                    for (int bj = 0; bj < 2; ++bj) { const f32x4 v0 = acc[ai][bj][m][0] * sc, v1 = acc[ai][bj][m][1] * sc;
                        u32x4 w; w.x = cvt_pk_bf16(v0[0], v0[1]); w.y = cvt_pk_bf16(v0[2], v0[3]); w.z = cvt_pk_bf16(v1[0], v1[1]); w.w = cvt_pk_bf16(v1[2], v1[3]);
                        *(u32x4*)(rowp + bj * HALF) = w; } }
        }
    }
};
struct EpiPre1 {
    static constexpr bool PERM = true, AFTER_DRAIN = false;
    const float* xin; bf16_t* O; float* stats; int ldc; float alpha;
    __device__ __forceinline__ void operator()(const f32x4 (&acc)[2][2][4][2], const Unit& u, int wr, int wc, int fr, int fq) const {
        const int row0 = u.pm * BM + wr * 64 + fr, col0 = u.pn * BM + wc * 32 + 8 * fq;
#pragma unroll
        for (int ai = 0; ai < 2; ++ai) {
            f32x4 b[4][2][2];
#pragma unroll
            for (int m = 0; m < 4; ++m) { const size_t off = (size_t)(row0 + ai * HALF + m * 16) * ldc + col0;
#pragma unroll
                for (int bj = 0; bj < 2; ++bj) { b[m][bj][0] = *(const f32x4*)(xin + off + bj * HALF); b[m][bj][1] = *(const f32x4*)(xin + off + bj * HALF + 4); } }
#pragma unroll
            for (int m = 0; m < 4; ++m) { const int row = row0 + ai * HALF + m * 16; const size_t off = (size_t)row * ldc + col0;
                float s1 = 0.f, s2 = 0.f;
#pragma unroll
                for (int bj = 0; bj < 2; ++bj) { const f32x4 v0 = b[m][bj][0] * alpha + acc[ai][bj][m][0], v1 = b[m][bj][1] * alpha + acc[ai][bj][m][1];
                    s1 += ((v0[0] + v0[1]) + (v0[2] + v0[3])) + ((v1[0] + v1[1]) + (v1[2] + v1[3]));
                    s2 += ((v0[0] * v0[0] + v0[1] * v0[1]) + (v0[2] * v0[2] + v0[3] * v0[3])) + ((v1[0] * v1[0] + v1[1] * v1[1]) + (v1[2] * v1[2] + v1[3] * v1[3]));
                    u32x4 w; w.x = cvt_pk_bf16(v0[0], v0[1]); w.y = cvt_pk_bf16(v0[2], v0[3]); w.z = cvt_pk_bf16(v1[0], v1[1]); w.w = cvt_pk_bf16(v1[2], v1[3]);
                    *(u32x4*)(O + off + bj * HALF) = w; }
                s1 += __shfl_xor(s1, 16); s2 += __shfl_xor(s2, 16); s1 += __shfl_xor(s1, 32); s2 += __shfl_xor(s2, 32);
                if (fq == 0) { unsafeAtomicAdd(stats + 2 * row, s1); unsafeAtomicAdd(stats + 2 * row + 1, s2); } }
            asm volatile("" ::: "memory");
        }
    }
};
struct EpiSqReluLn {
    static constexpr bool PERM = true, AFTER_DRAIN = false;
    bf16_t* O; int ldc; const float* stats; const float* uvec; const float* cvec; float inv_n, eps;
    __device__ __forceinline__ void operator()(const f32x4 (&acc)[2][2][4][2], const Unit& u, int wr, int wc, int fr, int fq) const {
        const int row0 = u.pm * BM + wr * 64 + fr, col0 = u.pn * BM + wc * 32 + 8 * fq;
        f32x4 uv[2][2], cv[2][2];
#pragma unroll
        for (int bj = 0; bj < 2; ++bj)
#pragma unroll
            for (int n = 0; n < 2; ++n) { uv[bj][n] = *(const f32x4*)(uvec + col0 + bj * HALF + 4 * n); cv[bj][n] = *(const f32x4*)(cvec + col0 + bj * HALF + 4 * n); }
        f32x2 st[2][4];
#pragma unroll
        for (int ai = 0; ai < 2; ++ai)
#pragma unroll
            for (int m = 0; m < 4; ++m) st[ai][m] = *(const f32x2*)(stats + 2 * (row0 + ai * HALF + m * 16));
#pragma unroll
        for (int ai = 0; ai < 2; ++ai)
#pragma unroll
            for (int m = 0; m < 4; ++m) { const int row = row0 + ai * HALF + m * 16; bf16_t* rowp = O + (size_t)row * ldc + col0;
                const float s1 = st[ai][m][0], s2 = st[ai][m][1];
                const float mu = s1 * inv_n, var = fmaxf(s2 * inv_n - mu * mu, 0.f), r = 1.0f / sqrtf(var + eps), mr = -mu * r;
#pragma unroll
                for (int bj = 0; bj < 2; ++bj) { f32x4 v0 = acc[ai][bj][m][0] * r + (uv[bj][0] * mr + cv[bj][0]), v1 = acc[ai][bj][m][1] * r + (uv[bj][1] * mr + cv[bj][1]);
#pragma unroll
                    for (int e = 0; e < 4; ++e) { const float a = fmaxf(v0[e], 0.f), b = fmaxf(v1[e], 0.f); v0[e] = a * a; v1[e] = b * b; }
                    u32x4 w; w.x = cvt_pk_bf16(v0[0], v0[1]); w.y = cvt_pk_bf16(v0[2], v0[3]); w.z = cvt_pk_bf16(v1[0], v1[1]); w.w = cvt_pk_bf16(v1[2], v1[3]);
                    *(u32x4*)(rowp + bj * HALF) = w; } }
    }
};
struct EpiResidLn {
    static constexpr bool PERM = true, AFTER_DRAIN = false;
    const bf16_t* P; bf16_t* O; float* stats2; int ldc; const float* stats; const float* gvec; const float* bvec; float alpha, inv_n, eps;
    __device__ __forceinline__ void operator()(const f32x4 (&acc)[2][2][4][2], const Unit& u, int wr, int wc, int fr, int fq) const {
        const int row0 = u.pm * BM + wr * 64 + fr, col0 = u.pn * BM + wc * 32 + 8 * fq;
#pragma unroll
        for (int bj = 0; bj < 2; ++bj) {
            const f32x4 g0 = *(const f32x4*)(gvec + col0 + bj * HALF) * alpha, g1 = *(const f32x4*)(gvec + col0 + bj * HALF + 4) * alpha;
            const f32x4 b0 = *(const f32x4*)(bvec + col0 + bj * HALF) * alpha, b1 = *(const f32x4*)(bvec + col0 + bj * HALF + 4) * alpha;
#pragma unroll
            for (int ai = 0; ai < 2; ++ai) {
                u32x4 pz[4]; float mu[4], rs[4];
#pragma unroll
                for (int m = 0; m < 4; ++m) { const int row = row0 + ai * HALF + m * 16;
                    pz[m] = *(const u32x4*)(P + (size_t)row * ldc + col0 + bj * HALF);
                    const float s1 = stats[2 * row], s2 = stats[2 * row + 1]; mu[m] = s1 * inv_n; rs[m] = 1.0f / sqrtf(fmaxf(s2 * inv_n - mu[m] * mu[m], 0.f) + eps); }
#pragma unroll
                for (int m = 0; m < 4; ++m) { const int row = row0 + ai * HALF + m * 16; const u32x4 w = pz[m];
                    f32x4 p0, p1;
                    p0[0] = __uint_as_float(w.x << 16); p0[1] = __uint_as_float(w.x & 0xffff0000u); p0[2] = __uint_as_float(w.y << 16); p0[3] = __uint_as_float(w.y & 0xffff0000u);
                    p1[0] = __uint_as_float(w.z << 16); p1[1] = __uint_as_float(w.z & 0xffff0000u); p1[2] = __uint_as_float(w.w << 16); p1[3] = __uint_as_float(w.w & 0xffff0000u);
                    const f32x4 o0 = ((p0 - mu[m]) * rs[m]) * g0 + b0 + acc[ai][bj][m][0], o1 = ((p1 - mu[m]) * rs[m]) * g1 + b1 + acc[ai][bj][m][1];
                    float t1 = ((o0[0] + o0[1]) + (o0[2] + o0[3])) + ((o1[0] + o1[1]) + (o1[2] + o1[3]));
                    float t2 = ((o0[0] * o0[0] + o0[1] * o0[1]) + (o0[2] * o0[2] + o0[3] * o0[3])) + ((o1[0] * o1[0] + o1[1] * o1[1]) + (o1[2] * o1[2] + o1[3] * o1[3]));
                    u32x4 q; q.x = cvt_pk_bf16(o0[0], o0[1]); q.y = cvt_pk_bf16(o0[2], o0[3]); q.z = cvt_pk_bf16(o1[0], o1[1]); q.w = cvt_pk_bf16(o1[2], o1[3]);
                    *(u32x4*)(O + (size_t)row * ldc + col0 + bj * HALF) = q;
                    t1 += __shfl_xor(t1, 16); t2 += __shfl_xor(t2, 16); t1 += __shfl_xor(t1, 32); t2 += __shfl_xor(t2, 32);
                    if (fq == 0) { unsafeAtomicAdd(stats2 + 2 * row, t1); unsafeAtomicAdd(stats2 + 2 * row + 1, t2); } }
                asm volatile("" ::: "memory");
            }
        }
    }
};

template <class Epi, class Sched, bool ALIGN_EPI = false, bool SP2 = false>
__device__ __forceinline__ void gemm_phase(PG8_LAS unsigned char* lds, const Gemm g, const Sched& S, const Epi& E, int wid) {
    int lane_; asm volatile("v_mbcnt_lo_u32_b32 %0, -1, 0\n\tv_mbcnt_hi_u32_b32 %0, -1, %0" : "=v"(lane_));
    const int lane = lane_, tid = wid * 64 + lane, wr = wid >> 2, wc = wid & 3, fr = lane & 15, fq = lane >> 4;
    const int K = g.K, nt = K / BK;
    unsigned voffA[2], voffB[2];
#pragma unroll
    for (int i = 0; i < 2; ++i) { int R, C; stage_rc(tid * 16 + i * 8192, R, C); const int Rb = Epi::PERM ? ((R & ~31) + perm32(R & 31)) : R;
        voffA[i] = (unsigned)(R * K + C) * 2u; voffB[i] = (unsigned)(Rb * K + C) * 2u; }
    const size_t kstep = (size_t)(BK * 2);
    const size_t hstep = (size_t)HALF * K * 2;
    const size_t tstep = 2 * hstep;
    const unsigned ldsw = (unsigned)wid * 1024u;
    const int aoff = lds_byte(wr * 64 + fr, fq * 8), boff = lds_byte(wc * 32 + fr, fq * 8);
#define PG8_SA(b, h) (((b) * 2 + (h)) * HTB)
#define PG8_SB(b, h) ((4 + (b) * 2 + (h)) * HTB)
#define PG8_STAGE(bufoff, gbase, voff) do { _Pragma("unroll") for (int _i = 0; _i < 2; ++_i) \
        __builtin_amdgcn_global_load_lds((const unsigned*)((const char*)(gbase) + (voff)[_i]), (PG8_LAS unsigned*)(lds + (bufoff) + ldsw + _i * 8192), 16, 0, 0); } while (0)
#define PG8_LDA(dst, b, h) do { _Pragma("unroll") for (int m = 0; m < 4; ++m) _Pragma("unroll") for (int k = 0; k < 2; ++k) dst[m][k] = *(const PG8_LAS bf16x8*)(lds + PG8_SA(b, h) + aoff + m * 2048 + k * 1024); } while (0)
#define PG8_LDB(dst, b, h) do { _Pragma("unroll") for (int n = 0; n < 2; ++n) _Pragma("unroll") for (int k = 0; k < 2; ++k) dst[n][k] = *(const PG8_LAS bf16x8*)(lds + PG8_SB(b, h) + boff + n * 2048 + k * 1024); } while (0)
#define PG8_MMA(ai, bj, At, Bt) do { __builtin_amdgcn_s_setprio(1); _Pragma("unroll") for (int m = 0; m < 4; ++m) _Pragma("unroll") for (int n = 0; n < 2; ++n) _Pragma("unroll") for (int k = 0; k < 2; ++k) \
        acc[ai][bj][m][n] = __builtin_amdgcn_mfma_f32_16x16x32_bf16(Bt[n][k], At[m][k], acc[ai][bj][m][n], 0, 0, 0); __builtin_amdgcn_s_setprio(0); } while (0)
#define PG8_WAIT_V(n) asm volatile("s_waitcnt vmcnt(" #n ")" ::: "memory")
#define PG8_WAIT_L(n) asm volatile("s_waitcnt lgkmcnt(" #n ")" ::: "memory")
#define PG8_BAR __builtin_amdgcn_s_barrier()
#define PG8_SCHED __builtin_amdgcn_sched_barrier(0)
    Unit cur, nxt; int ui = 0;
    if (!S.next(0, cur)) return;
    f32x4 acc[2][2][4][2];
#pragma unroll
    for (int a = 0; a < 2; ++a)
#pragma unroll
        for (int b = 0; b < 2; ++b)
#pragma unroll
            for (int m = 0; m < 4; ++m)
#pragma unroll
                for (int n = 0; n < 2; ++n) acc[a][b][m][n] = (f32x4){0.f, 0.f, 0.f, 0.f};
    bf16x8 At[4][2], B0[2][2], B1[2][2];
    const char* cA = (const char*)g.A + (size_t)cur.pm * tstep; const char* cB = (const char*)g.Bt + (size_t)cur.pn * tstep;
    S.a_ready(cur);
    if constexpr (SP2) {
        PG8_STAGE(PG8_SB(0, 0), cB, voffB); PG8_STAGE(PG8_SB(0, 1), cB + hstep, voffB); PG8_STAGE(PG8_SA(0, 0), cA, voffA); PG8_STAGE(PG8_SA(0, 1), cA + hstep, voffA);
        if (wr == 1) PG8_BAR;
        PG8_WAIT_V(2); PG8_BAR;
        PG8_STAGE(PG8_SB(1, 0), cB + kstep, voffB); PG8_STAGE(PG8_SA(1, 0), cA + kstep, voffA); PG8_STAGE(PG8_SB(1, 1), cB + hstep + kstep, voffB);
        PG8_WAIT_V(6); PG8_BAR;
    } else {
        PG8_STAGE(PG8_SB(0, 0), cB, voffB); PG8_STAGE(PG8_SA(0, 0), cA, voffA); PG8_STAGE(PG8_SB(0, 1), cB + hstep, voffB); PG8_STAGE(PG8_SA(0, 1), cA + hstep, voffA);
        if (wr == 1) PG8_BAR;
        PG8_WAIT_V(4); PG8_BAR;
        PG8_STAGE(PG8_SB(1, 0), cB + kstep, voffB); PG8_STAGE(PG8_SA(1, 0), cA + kstep, voffA); PG8_STAGE(PG8_SB(1, 1), cB + hstep + kstep, voffB);
        PG8_WAIT_V(6); PG8_BAR;
    }
    for (;;) {
        const bool has_next = S.next(ui + 1, nxt);
        const char* nA = has_next ? (const char*)g.A + (size_t)nxt.pm * tstep : cA; const char* nB = has_next ? (const char*)g.Bt + (size_t)nxt.pn * tstep : cB;
        for (int t = 0; t < nt; t += 2) {
            const bool last = (t == nt - 2);
            const char* a1 = cA + (size_t)(t + 1) * kstep;
            const char* a2 = last ? nA : cA + (size_t)(t + 2) * kstep; const char* b2 = last ? nB : cB + (size_t)(t + 2) * kstep;
            const char* a3 = a2 + kstep; const char* b3 = b2 + kstep;
            if (last && has_next) S.a_ready(nxt);
            if constexpr (SP2) {
            PG8_LDB(B0, 0, 0); PG8_LDB(B1, 0, 1); PG8_SCHED; PG8_LDA(At, 0, 0); PG8_STAGE(PG8_SA(1, 1), a1 + hstep, voffA);
            PG8_WAIT_V(8); PG8_WAIT_L(0); PG8_BAR; PG8_MMA(0, 0, At, B0); PG8_MMA(0, 1, At, B1); PG8_BAR; PG8_SCHED;
            PG8_LDA(At, 0, 1); PG8_STAGE(PG8_SB(0, 0), b2, voffB); PG8_STAGE(PG8_SB(0, 1), b2 + hstep, voffB); PG8_STAGE(PG8_SA(0, 0), a2, voffA);
            PG8_WAIT_V(8); PG8_WAIT_L(0); PG8_BAR; PG8_MMA(1, 0, At, B0); PG8_MMA(1, 1, At, B1); PG8_BAR; PG8_SCHED;
            PG8_LDB(B0, 1, 0); PG8_LDB(B1, 1, 1); PG8_SCHED; PG8_LDA(At, 1, 0); PG8_STAGE(PG8_SA(0, 1), a2 + hstep, voffA);
            PG8_WAIT_V(8); PG8_WAIT_L(0); PG8_BAR; PG8_MMA(0, 0, At, B0); PG8_MMA(0, 1, At, B1); PG8_BAR; PG8_SCHED;
            PG8_LDA(At, 1, 1); PG8_STAGE(PG8_SB(1, 0), b3, voffB); PG8_STAGE(PG8_SB(1, 1), b3 + hstep, voffB); PG8_STAGE(PG8_SA(1, 0), a3, voffA);
            PG8_WAIT_V(8); PG8_WAIT_L(0); PG8_BAR; PG8_MMA(1, 0, At, B0); PG8_MMA(1, 1, At, B1); PG8_BAR; PG8_SCHED;
            } else {
            PG8_LDB(B0, 0, 0); PG8_SCHED; PG8_LDA(At, 0, 0); PG8_STAGE(PG8_SA(1, 1), a1 + hstep, voffA);
            PG8_WAIT_L(8); PG8_BAR; PG8_WAIT_L(0); PG8_MMA(0, 0, At, B0); PG8_BAR; PG8_SCHED;
            PG8_LDB(B1, 0, 1); PG8_STAGE(PG8_SB(0, 0), b2, voffB);
            PG8_BAR; PG8_WAIT_L(0); PG8_MMA(0, 1, At, B1); PG8_BAR;
            PG8_LDA(At, 0, 1); PG8_STAGE(PG8_SA(0, 0), a2, voffA);
            PG8_BAR; PG8_WAIT_L(0); PG8_MMA(1, 0, At, B0); PG8_BAR; PG8_SCHED;
            PG8_STAGE(PG8_SB(0, 1), b2 + hstep, voffB);
            PG8_WAIT_V(6); PG8_BAR; PG8_MMA(1, 1, At, B1); PG8_BAR;
            PG8_LDB(B0, 1, 0); PG8_SCHED; PG8_LDA(At, 1, 0); PG8_STAGE(PG8_SA(0, 1), a2 + hstep, voffA);
            PG8_WAIT_L(8); PG8_BAR; PG8_WAIT_L(0); PG8_MMA(0, 0, At, B0); PG8_BAR; PG8_SCHED;
            PG8_LDB(B1, 1, 1); PG8_STAGE(PG8_SB(1, 0), b3, voffB);
            PG8_BAR; PG8_WAIT_L(0); PG8_MMA(0, 1, At, B1); PG8_BAR;
            PG8_LDA(At, 1, 1); PG8_STAGE(PG8_SA(1, 0), a3, voffA);
            PG8_BAR; PG8_WAIT_L(0); PG8_MMA(1, 0, At, B0); PG8_BAR; PG8_SCHED;
            PG8_STAGE(PG8_SB(1, 1), b3 + hstep, voffB);
            PG8_WAIT_V(6); PG8_BAR; PG8_MMA(1, 1, At, B1); PG8_BAR;
            }
        }
        if constexpr (ALIGN_EPI) { if (wr == 0) PG8_BAR; }
        if constexpr (!Epi::AFTER_DRAIN) { E(acc, cur, wr, wc, fr, fq); S.done(cur); }
        if (!has_next) break;
#pragma unroll
        for (int a = 0; a < 2; ++a)
#pragma unroll
            for (int b = 0; b < 2; ++b)
#pragma unroll
                for (int m = 0; m < 4; ++m)
#pragma unroll
                    for (int n = 0; n < 2; ++n) acc[a][b][m][n] = (f32x4){0.f, 0.f, 0.f, 0.f};
        cur = nxt; cA = nA; cB = nB; ++ui;
        if constexpr (ALIGN_EPI) { if (wr == 1) PG8_BAR; }
    }
    PG8_WAIT_V(0);
    if constexpr (!ALIGN_EPI) { if (wr == 0) PG8_BAR; }
    PG8_BAR;
    if constexpr (Epi::AFTER_DRAIN) { E.fused(acc, cur, wr, wc, fr, fq, lds, wid, lane); S.done(cur); }
#undef PG8_SA
#undef PG8_SB
#undef PG8_STAGE
#undef PG8_LDA
#undef PG8_LDB
#undef PG8_MMA
#undef PG8_WAIT_V
#undef PG8_WAIT_L
#undef PG8_BAR
#undef PG8_SCHED
}
}
namespace att {
typedef unsigned short bf16;
typedef short bf16x8 __attribute__((ext_vector_type(8)));
typedef short s16x4 __attribute__((ext_vector_type(4)));
typedef float f32x16 __attribute__((ext_vector_type(16)));
typedef float f32x4 __attribute__((ext_vector_type(4)));
typedef unsigned u32x4 __attribute__((ext_vector_type(4)));
constexpr int D = 128, PITCH = 12288, NW = 8, QBLK = 32, KVBLK = 64, QB = NW * QBLK;
constexpr int SHM_V = KVBLK * D * 2, SHM_K = KVBLK * D * 2;
constexpr int SHM_V2 = 2 * SHM_V;
constexpr int OFF_K = 2 * SHM_V2, OFF_WS = OFF_K + 2 * SHM_K, OFF_BIAS = OFF_WS + NW * 64 * 4, OFF_MISC = OFF_BIAS + 384 * 4, LDS_BYTES = OFF_MISC + 64;
constexpr float THR = 8.f;
#define KSWZ(row, colB) ((row) * 256 + ((colB) ^ (((row) & 7) << 4)))
#define SBAR() __builtin_amdgcn_sched_barrier(0)
__device__ __forceinline__ int v_st(int k, int c) { const int kk = (k & ~0xC) | ((k & 4) << 1) | ((k & 8) >> 1); return ((kk >> 3) * 4 + (c >> 5)) * 512 + ((kk & 7) * 32 + (c & 31)) * 2; }
__device__ __forceinline__ int v_rd_base(int lane) { return ((lane & 3) << 3) | (((lane >> 2) & 3) << 6) | (((lane >> 4) & 1) << 5) | (((lane >> 5) & 1) << 8); }
constexpr int v_rd_off(int d0, int ks, int half) { return d0 * 512 + ks * 4096 + half * 2048; }
__device__ __forceinline__ int crow(int r, int hi) { return (r & 3) + 8 * (r >> 2) + 4 * hi; }
__device__ __forceinline__ unsigned cvtpk(float lo, float hi) { unsigned r; asm volatile("v_cvt_pk_bf16_f32 %0, %1, %2" : "=v"(r) : "v"(lo), "v"(hi)); return r; }
__device__ __forceinline__ bf16x8 load8(const bf16* p) { return *reinterpret_cast<const bf16x8*>(p); }
__device__ __forceinline__ void mask_tile(f32x16& p0, f32x16& p1, int dq) {
    const float NEG = -__builtin_inff();
#pragma unroll
    for (int r = 0; r < 16; ++r) { const int c = (r & 3) + 8 * (r >> 2); if (dq - c < 0) p0[r] = NEG; if (dq - c - 32 < 0) p1[r] = NEG; }
}
__device__ __forceinline__ void bias_tile(f32x16& p0, f32x16& p1, int dq, const float* T) {
    const float* tp = T + dq;
#pragma unroll
    for (int r = 0; r < 16; ++r) { const int c = (r & 3) + 8 * (r >> 2); p0[r] += tp[128 - c]; p1[r] += tp[96 - c]; }
}
#define ATT_PK4(P, B_, OUT) do { unsigned a0 = cvtpk(P[B_+0], P[B_+1]), a1 = cvtpk(P[B_+2], P[B_+3]);                          \
        unsigned b0 = cvtpk(P[B_+4], P[B_+5]), b1 = cvtpk(P[B_+6], P[B_+7]);                                             \
        auto r0 = __builtin_amdgcn_permlane32_swap(a0, b0, false, false); auto r1 = __builtin_amdgcn_permlane32_swap(a1, b1, false, false); \
        u32x4 w = {r0[0], r1[0], r0[1], r1[1]}; OUT = *reinterpret_cast<bf16x8*>(&w); } while (0)
__device__ __forceinline__ void softmax_tile(f32x16& p0, f32x16& p1, float& m_reg, float& l_reg, float& alpha, bf16x8& pa0, bf16x8& pa1, bf16x8& pa2, bf16x8& pa3) {
    float pmax = p0[0]; for (int r = 1; r < 16; ++r) pmax = fmaxf(pmax, p0[r]); for (int r = 0; r < 16; ++r) pmax = fmaxf(pmax, p1[r]);
    { auto rr = __builtin_amdgcn_permlane32_swap(__float_as_uint(pmax), __float_as_uint(pmax), false, false);
      pmax = fmaxf(__uint_as_float(rr[0]), __uint_as_float(rr[1])); }
    float mn;
    if (__builtin_expect(__all((pmax - m_reg) <= THR), 1)) { mn = m_reg; alpha = 1.f; }
    else { mn = fmaxf(m_reg, pmax); alpha = __builtin_amdgcn_exp2f(m_reg - mn); m_reg = mn; }
    for (int r = 0; r < 16; ++r) p0[r] = __builtin_amdgcn_exp2f(p0[r] - mn);
    for (int r = 0; r < 16; ++r) p1[r] = __builtin_amdgcn_exp2f(p1[r] - mn);
    float ps = 0; for (int r = 0; r < 16; ++r) ps += p0[r]; for (int r = 0; r < 16; ++r) ps += p1[r];
    { auto rr = __builtin_amdgcn_permlane32_swap(__float_as_uint(ps), __float_as_uint(ps), false, false);
      ps = __uint_as_float(rr[0]) + __uint_as_float(rr[1]); }
    l_reg = l_reg * alpha + ps;
    ATT_PK4(p0, 0, pa0); ATT_PK4(p0, 8, pa1); ATT_PK4(p1, 0, pa2); ATT_PK4(p1, 8, pa3);
}
template <int KB>
__device__ __forceinline__ void qkt(f32x16& p0, f32x16& p1, const char* K_lds, int r32, int hi, const bf16x8* qr) {
    p0 = f32x16{}; p1 = f32x16{};
    const char* kb[4];
#pragma unroll
    for (int dd = 0; dd < 4; ++dd) kb[dd] = K_lds + KB * SHM_K + KSWZ(r32, (dd * 16 + hi * 8) * 2);
#pragma unroll
    for (int d0 = 0; d0 < 8; d0 += 2) {
        const char* a0 = kb[d0 & 3] + (d0 >> 2) * 128; const char* a1 = kb[(d0 + 1) & 3] + ((d0 + 1) >> 2) * 128;
        const bf16x8 b00 = *reinterpret_cast<const bf16x8*>(a0), b01 = *reinterpret_cast<const bf16x8*>(a0 + 32 * 256);
        const bf16x8 b10 = *reinterpret_cast<const bf16x8*>(a1), b11 = *reinterpret_cast<const bf16x8*>(a1 + 32 * 256);
        p0 = __builtin_amdgcn_mfma_f32_32x32x16_bf16(b00, qr[d0], p0, 0, 0, 0);
        p1 = __builtin_amdgcn_mfma_f32_32x32x16_bf16(b01, qr[d0], p1, 0, 0, 0);
        p0 = __builtin_amdgcn_mfma_f32_32x32x16_bf16(b10, qr[d0 + 1], p0, 0, 0, 0);
        p1 = __builtin_amdgcn_mfma_f32_32x32x16_bf16(b11, qr[d0 + 1], p1, 0, 0, 0);
        SBAR(); }
}
#define ATT_TRRD(dst, base, off) asm volatile("ds_read_b64_tr_b16 %0, %1 offset:%2" : "=&v"(dst) : "v"(base), "i"(off) : "memory")
template <int VB>
__device__ __forceinline__ void pv_tile(f32x16* o, int vb0, bf16x8 pa0, bf16x8 pa1, bf16x8 pa2, bf16x8 pa3) {
#define PV_D0(d0) do { s16x4 l0, l1, l2, l3, h0, h1, h2, h3; constexpr int b_ = VB * SHM_V2 + ((d0) >> 2) * SHM_V + v_rd_off((d0) & 3, 0, 0); \
        ATT_TRRD(l0, vb0, b_); ATT_TRRD(h0, vb0, b_ + 2048); ATT_TRRD(l1, vb0, b_ + 4096); ATT_TRRD(h1, vb0, b_ + 6144); ATT_TRRD(l2, vb0, b_ + 8192); ATT_TRRD(h2, vb0, b_ + 10240); ATT_TRRD(l3, vb0, b_ + 12288); ATT_TRRD(h3, vb0, b_ + 14336); \
        asm volatile("s_waitcnt lgkmcnt(0)" ::: "memory"); SBAR();   \
        o[d0] = __builtin_amdgcn_mfma_f32_32x32x16_bf16(pa0, (bf16x8){l0[0], l0[1], l0[2], l0[3], h0[0], h0[1], h0[2], h0[3]}, o[d0], 0, 0, 0);   \
        o[d0] = __builtin_amdgcn_mfma_f32_32x32x16_bf16(pa1, (bf16x8){l1[0], l1[1], l1[2], l1[3], h1[0], h1[1], h1[2], h1[3]}, o[d0], 0, 0, 0);   \
        o[d0] = __builtin_amdgcn_mfma_f32_32x32x16_bf16(pa2, (bf16x8){l2[0], l2[1], l2[2], l2[3], h2[0], h2[1], h2[2], h2[3]}, o[d0], 0, 0, 0);   \
        o[d0] = __builtin_amdgcn_mfma_f32_32x32x16_bf16(pa3, (bf16x8){l3[0], l3[1], l3[2], l3[3], h3[0], h3[1], h3[2], h3[3]}, o[d0], 0, 0, 0); } while (0)
    PV_D0(0); PV_D0(1); PV_D0(2); PV_D0(3); PV_D0(4); PV_D0(5); PV_D0(6); PV_D0(7);
#undef PV_D0
}
struct BlockRef { const bf16* Q; const bf16* K; const bf16* V; float* O; bf16* mixrow; int P0; int m; };
#define ROW(p, k0, rr) ((p) + (size_t)((k0) + (rr)) * PITCH + sc)
#define VMW() asm volatile("s_waitcnt vmcnt(0)" ::: "memory")
__device__ __forceinline__ float ld_sc1(const float* p) { return __uint_as_float(__hip_atomic_load((const unsigned*)p, __ATOMIC_RELAXED, __HIP_MEMORY_SCOPE_AGENT)); }
typedef __attribute__((address_space(3))) unsigned char* lds_ptr;
__device__ __forceinline__ void block(const BlockRef& cur, lds_ptr ldsa, float lam, const float* gain, float oscale, int wid) {
    int lane_; asm volatile("v_mbcnt_lo_u32_b32 %0, -1, 0\n\tv_mbcnt_hi_u32_b32 %0, -1, %0" : "=v"(lane_));
    const int lane = lane_, tid = wid * 64 + lane, r32 = lane & 31, hi = lane >> 5;
    char* lds = (char*)ldsa;
    const int NT = (cur.P0 + QB) / KVBLK;
    const int qlo = cur.P0 + wid * QBLK, qm = qlo + r32 - 4 * hi;
    char* V_lds = lds; char* K_lds = lds + OFF_K;
    float* ws = (float*)(lds + OFF_WS) + wid * 64; float* li_l = ws, * al_l = ws + 32;
    const float* bias_l = (const float*)(lds + OFF_BIAS);
    const int vb0 = (int)(uintptr_t)V_lds + v_rd_base(lane);
    const bf16* Kh = cur.K; const bf16* Vh = cur.V;
    unsigned koff[2], voff[2];
#pragma unroll
    for (int j = 0; j < 2; ++j) { const int pc = wid + 8 * j;
        { const int row = 4 * pc + (lane >> 4), c16 = (lane & 15) ^ (row & 7); koff[j] = (unsigned)(row * PITCH + c16 * 8) * 2u; }
        { const int sb = 2 * pc + (lane >> 5), kk = (sb >> 2) * 8 + ((lane & 31) >> 2), c = (sb & 3) * 32 + (lane & 3) * 8, k = (kk & ~0xC) | ((kk & 4) << 1) | ((kk & 8) >> 1);
          voff[j] = (unsigned)(k * PITCH + c) * 2u; } }
#define DMA16(gp, loff) __builtin_amdgcn_global_load_lds((const unsigned*)(gp), (__attribute__((address_space(3))) unsigned*)(ldsa + (loff)), 16, 0, 0)
#define STAGE(k0, bf) do { const char* vt_ = (const char*)(Vh + (size_t)(k0) * PITCH); const char* kt_ = (const char*)(Kh + (size_t)(k0) * PITCH); \
        _Pragma("unroll") for (int j_ = 0; j_ < 2; ++j_) { const int pc_ = (wid + 8 * j_) * 1024; \
            DMA16(kt_ + koff[j_], OFF_K + (bf) * SHM_K + pc_); DMA16(vt_ + voff[j_], (bf) * SHM_V2 + pc_); DMA16(vt_ + voff[j_] + 256, (bf) * SHM_V2 + SHM_V + pc_); } } while (0)
    STAGE(0, 0);
    bf16x8 qr[8];
#pragma unroll
    for (int d0 = 0; d0 < 8; ++d0) qr[d0] = load8(cur.Q + (size_t)(wid * QBLK + r32) * PITCH + d0 * 16 + hi * 8);
    VMW();
    __syncthreads();
    float m_reg = -1e30f, l_reg = 0; f32x16 o[8] = {};
#define KBASE(t) ((t) * KVBLK)
#define MASKT(P0_, P1_, t) do { const int kb_ = KBASE(t); if (kb_ + KVBLK - 1 > qlo - 128 && kb_ <= qlo + QBLK - 1) bias_tile(P0_, P1_, qm - kb_, bias_l); \
                                if (kb_ + KVBLK - 1 > qlo) mask_tile(P0_, P1_, qm - kb_); } while (0)
#define STEP(t, BF, SB) do { f32x16 p0, p1; float alpha; bf16x8 pa0, pa1, pa2, pa3;                                      \
        if ((t) + 1 < NT) { STAGE(KBASE((t) + 1), SB); } SBAR();                                                          \
        if (KBASE(t) <= qlo + QBLK - 1) {        \
        qkt<BF>(p0, p1, K_lds, r32, hi, qr); SBAR();                                                                     \
        MASKT(p0, p1, (t)); softmax_tile(p0, p1, m_reg, l_reg, alpha, pa0, pa1, pa2, pa3);                               \
        if (__any(alpha < 1.f)) { if (hi == 0) al_l[r32] = alpha; asm volatile("s_waitcnt lgkmcnt(0)" ::: "memory");      \
            for (int d_ = 0; d_ < 8; ++d_) for (int r = 0; r < 16; ++r) o[d_][r] *= al_l[crow(r, hi)]; }                  \
        SBAR(); pv_tile<BF>(o, vb0, pa0, pa1, pa2, pa3); SBAR(); }                                                        \
        VMW(); __syncthreads(); } while (0)
    for (int t = 0; t < NT; t += 2) { STEP(t, 0, 1); STEP(t + 1, 1, 0); }
    if (hi == 0) li_l[r32] = l_reg; asm volatile("s_waitcnt lgkmcnt(0)" ::: "memory");
    float* Ow = cur.O + (size_t)(wid * QBLK) * 256 + r32;
    if (cur.m == 0) {
#pragma unroll
        for (int r = 0; r < 16; ++r) { const int orow = crow(r, hi); const float rl = __builtin_amdgcn_rcpf(li_l[orow]);
#pragma unroll
            for (int d0 = 0; d0 < 8; ++d0) Ow[(size_t)orow * 256 + d0 * 32] = o[d0][r] * rl; }
    } else {
        VMW();
        float g[8];
#pragma unroll
        for (int d0 = 0; d0 < 8; ++d0) g[d0] = gain[d0 * 32 + r32] * oscale;
        bf16* mw = cur.mixrow + (size_t)(wid * QBLK) * 4096 + r32;
#pragma unroll
        for (int rg = 0; rg < 16; rg += 4) {
            float v[4][8];
#pragma unroll
            for (int q = 0; q < 4; ++q) { const int orow = crow(rg + q, hi);
#pragma unroll
                for (int d0 = 0; d0 < 8; ++d0) v[q][d0] = ld_sc1(Ow + (size_t)orow * 256 + d0 * 32); }
#pragma unroll
            for (int q = 0; q < 4; ++q) { const int r = rg + q, orow = crow(r, hi); const float rl = lam * __builtin_amdgcn_rcpf(li_l[orow]);
                float ss = 0.f;
#pragma unroll
                for (int d0 = 0; d0 < 8; ++d0) { v[q][d0] -= o[d0][r] * rl; ss += v[q][d0] * v[q][d0]; }
#pragma unroll
                for (int sft = 1; sft < 32; sft <<= 1) ss += __shfl_xor(ss, sft);
                const float rs = 1.0f / sqrtf(ss * (1.0f / 256.0f) + 1e-5f);
#pragma unroll
                for (int d0 = 0; d0 < 8; ++d0) { const float y = v[q][d0] * rs * g[d0]; const float yn = __shfl_xor(y, 1);
                    if ((r32 & 1) == 0) *(unsigned*)(mw + (size_t)orow * 4096 + d0 * 32) = cvtpk(y, yn); } }
            asm volatile("" ::: "memory"); }
    }
    __syncthreads();
#undef DMA16
#undef STAGE
#undef KBASE
#undef MASKT
#undef STEP
}
#undef ROW
#undef VMW
}

constexpr int NWAVES = 8;
#ifndef MK_N_LAUNCHES
#define MK_N_LAUNCHES 1
#endif
constexpr int N_PHASES = 8;
constexpr int N_LAUNCHES = MK_N_LAUNCHES;
static_assert(N_LAUNCHES == 1 || N_LAUNCHES == N_PHASES, "MK_N_LAUNCHES is 1 or N_PHASES");

constexpr int SEQ = 8192, DM = 4096, M = 2 * SEQ, NPROJ = 12288, DFF = 16384;
constexpr int C_AQ = 0, C_AK = 2048, C_AV = 4096, C_RQ = 6144, C_RK = 7168, C_RV = 8192, C_RG = 10240;
constexpr float LN_EPS = 1e-5f;
constexpr float ALPHA = 1.189207115002721f;
constexpr float LAMBDA_INIT = 0.3555090675732191f;
constexpr float LOG2E = 1.4426950408889634f;

constexpr size_t MiB = 1u << 20;
constexpr size_t WS_CTL = 0, CTL_ZERO_BYTES = 1 * MiB;
constexpr size_t WS_STATS = 65536;
constexpr size_t WS_UVEC = 196608;
constexpr size_t WS_CVEC = 262144;
constexpr size_t WS_STATS2 = 327680;
constexpr size_t WS_QUEUE = 458752;
constexpr size_t WS_ROPE = 1 * MiB;
constexpr size_t WS_DEC = 5 * MiB;
constexpr size_t WS_W1T = 8 * MiB;
constexpr size_t WS_PRE2 = 8 * MiB;
constexpr size_t WS_W2T = 136 * MiB;
constexpr size_t WS_XB = 264 * MiB;
constexpr size_t WS_SST = 264 * MiB;
constexpr size_t WS_RG = 328 * MiB;
constexpr size_t WS_PRE1 = 264 * MiB;
constexpr size_t WS_WINT = 392 * MiB;
constexpr size_t WS_MIX = 392 * MiB;
constexpr size_t WS_WOT = 520 * MiB;
constexpr size_t WS_PROJ = 552 * MiB;
constexpr size_t WS_ASCR = 936 * MiB;
constexpr size_t WS_H = 512 * MiB;
constexpr size_t WS_END = 1024 * MiB;
constexpr int CW_TMO = 0, CW_BAR = 4096;

constexpr int RING_OFF = 0, RING_BYTES = 131072;
constexpr int LDSCTL_OFF = RING_BYTES, MISC_OFF = LDSCTL_OFF + 320;
constexpr int LDS_BYTES = 147456;
static_assert(att::LDS_BYTES <= RING_BYTES, "attention LDS");

#define GAS __attribute__((address_space(1)))
#define LAS __attribute__((address_space(3)))
typedef unsigned short bf16;
typedef unsigned v4u __attribute__((ext_vector_type(4)));
typedef unsigned v2u __attribute__((ext_vector_type(2)));
typedef float f32x4 __attribute__((ext_vector_type(4)));
typedef float f32x16 __attribute__((ext_vector_type(16)));
typedef short bf16x8 __attribute__((ext_vector_type(8)));
typedef short s16x4 __attribute__((ext_vector_type(4)));
typedef GAS unsigned gu32;
typedef unsigned u32x4 __attribute__((ext_vector_type(4)));
using att::cvtpk;
#define RLX_AGENT __ATOMIC_RELAXED, __HIP_MEMORY_SCOPE_AGENT
#define LDS_WAIT() asm volatile("s_waitcnt lgkmcnt(0)" ::: "memory")
#define VM_WAIT() asm volatile("s_waitcnt vmcnt(0)" ::: "memory")
__device__ __forceinline__ unsigned f2bf(float f) { unsigned u = __builtin_bit_cast(unsigned, f); return (u + 0x7fffu + ((u >> 16) & 1u)) >> 16; }
__device__ __forceinline__ unsigned pk2(float lo, float hi) { return f2bf(lo) | (f2bf(hi) << 16); }
__device__ __forceinline__ float bf2f(unsigned short b) { return __builtin_bit_cast(float, (unsigned)b << 16); }

#define XB_TMO      128
#define XB_XCNT(j)  (256  + 64 * (j))
#define XB_XSUB(j)  (1280 + 64 * (j))
#define XB_XGEN(j)  (2304 + 64 * (j))
#define XB_TOP      3328
#define XB_TOPGEN   3392
#define XCD_BAR_WORDS 3456
#define XB_SPIN_CAP (1u << 18)

__device__ __forceinline__ unsigned xb_ld(unsigned* p)              { return __hip_atomic_load(p, __ATOMIC_RELAXED, __HIP_MEMORY_SCOPE_AGENT); }
__device__ __forceinline__ unsigned xb_add(unsigned* p, unsigned v) { return __hip_atomic_fetch_add(p, v, __ATOMIC_RELAXED, __HIP_MEMORY_SCOPE_AGENT); }
__device__ __forceinline__ unsigned xb_xcc_id() { return (unsigned)__builtin_amdgcn_s_getreg((3 << 11) | 20) & 0xFu; }
#define XB_SPIN(cond, bar) do { unsigned _sp = 0; while (cond) { __builtin_amdgcn_s_sleep(1); \
    if ((++_sp & 255u) == 0u) { if (xb_ld(&(bar)[XB_TMO])) break; if (_sp > XB_SPIN_CAP) { atomicAdd(&(bar)[XB_TMO], 1u); break; } } } } while (0)

struct XcdBarrier {
    unsigned* bar; unsigned x;
    volatile LAS unsigned* st;
};

__device__ __forceinline__ XcdBarrier xcd_barrier_post(unsigned* bar, volatile LAS unsigned* st, bool t0) {
    XcdBarrier b; b.bar = bar; b.x = xb_xcc_id(); b.st = st;
    if (t0) (void)xb_add(&bar[XB_XCNT(b.x)], 1u);
    return b;
}
__device__ __forceinline__ void xcd_barrier_complete(unsigned* bar, unsigned x, unsigned& nloc, unsigned& nx) {
    const unsigned G = gridDim.x * gridDim.y * gridDim.z;
    unsigned sum, cnt, mine, sp = 0u;
    for (;;) {
        sum = 0u; cnt = 0u; mine = 0u;
#pragma unroll
        for (unsigned j = 0; j < 16; ++j) { const unsigned c = xb_ld(&bar[XB_XCNT(j)]); sum += c; cnt += (c > 0u) ? 1u : 0u; mine = (j == x) ? c : mine; }
        if (sum == G) break;
        __builtin_amdgcn_s_sleep(1);
        if ((++sp & 255u) == 0u) { if (xb_ld(&bar[XB_TMO])) break; if (sp > XB_SPIN_CAP) { atomicAdd(&bar[XB_TMO], 1u); break; } }
    }
    nloc = mine > 0u ? mine : 1u; nx = cnt > 0u ? cnt : 1u;
}

__device__ __forceinline__ void xcd_barrier(const XcdBarrier& b, bool t0) {
    asm volatile("s_waitcnt vmcnt(0)" ::: "memory");
    __syncthreads();
    if (t0) {
        unsigned* bar = b.bar;
        __builtin_amdgcn_s_waitcnt(0);
        unsigned nloc = b.st[0], nx = b.st[1];
        if (nloc == 0u) { xcd_barrier_complete(bar, b.x, nloc, nx); b.st[0] = nloc; b.st[1] = nx; }
        const unsigned old = xb_add(&bar[XB_XSUB(b.x)], 1u);
        const unsigned gen = old / nloc;
        if (old + 1u == (gen + 1u) * nloc) {
            __builtin_amdgcn_fence(__ATOMIC_RELEASE, "agent");
            asm volatile("s_waitcnt vmcnt(0)" ::: "memory");
            const unsigned og = xb_add(&bar[XB_TOP], 1u);
            const unsigned tg = og / nx;
            if (og + 1u == (tg + 1u) * nx) xb_add(&bar[XB_TOPGEN], 1u);
            else XB_SPIN(xb_ld(&bar[XB_TOPGEN]) == tg, bar);
            __builtin_amdgcn_fence(__ATOMIC_ACQUIRE, "agent");
            xb_add(&bar[XB_XGEN(b.x)], 1u);
            asm volatile("s_waitcnt vmcnt(0)" ::: "memory");
        } else {
            XB_SPIN(xb_ld(&bar[XB_XGEN(b.x)]) == gen, bar);
            __builtin_amdgcn_fence(__ATOMIC_ACQUIRE, "agent");
            asm volatile("s_waitcnt vmcnt(0)" ::: "memory");
        }
    }
    __syncthreads();
}

struct Frame {
    LAS unsigned char* lds;
    volatile LAS unsigned* MISC;
    gu32* ctl;
    int tid, lane, wave;
    int vcu, G;
};
__device__ __forceinline__ float wave_sum(float v) {
#pragma unroll
    for (int o = 1; o < 64; o <<= 1) v += __shfl_xor(v, o);
    return v;
}
__device__ __forceinline__ void refresh_ids(Frame& F) { int l; asm volatile("v_mbcnt_lo_u32_b32 %0, -1, 0\n\tv_mbcnt_hi_u32_b32 %0, -1, %0" : "=v"(l)); F.lane = l; F.tid = F.wave * 64 + l; }
__device__ const unsigned char T5_BUCKET[128] = {0, 1, 2, 3, 4, 5, 6, 7, 8, 9, 10, 11, 12, 13, 14, 15, 16, 16, 16, 17, 17, 18, 18, 18, 19, 19, 19, 20, 20, 20, 20, 21, 21, 21, 21, 22, 22, 22, 22, 22, 23, 23, 23, 23, 23, 23, 24, 24, 24, 24, 24, 24, 25, 25, 25, 25, 25, 25, 25, 26, 26, 26, 26, 26, 26, 26, 26, 27, 27, 27, 27, 27, 27, 27, 27, 27, 27, 28, 28, 28, 28, 28, 28, 28, 28, 28, 28, 29, 29, 29, 29, 29, 29, 29, 29, 29, 29, 29, 29, 30, 30, 30, 30, 30, 30, 30, 30, 30, 30, 30, 30, 30, 30, 31, 31, 31, 31, 31, 31, 31, 31, 31, 31, 31, 31, 31, 31, 31};

__device__ __forceinline__ int win_dest_row(int n) {
    if (n >= C_RQ && n < C_RV) { const int r = n - C_RQ, hb = r & ~127, i = r & 127; return C_RQ + hb + (i < 64 ? 2 * i : 2 * (i - 64) + 1); }
    return n;
}
template <bool FOLD>
__device__ __forceinline__ void p0_transpose_item(const float* W, int K, int N, bf16* WT, LAS float* scr, int item, int lane, bool permute, const float* gvec, const float* bvec, float* uvec, float* cvec) {
    const int nblk = N / 32, kb = item / nblk, nb = item % nblk, k0 = 64 * kb, n0 = 32 * nb;
    f32x4 v[8];
#pragma unroll
    for (int i = 0; i < 8; ++i) { const int kk = 8 * i + (lane >> 3); v[i] = __builtin_nontemporal_load((const GAS f32x4*)(W + (size_t)(k0 + kk) * N + n0 + (lane & 7) * 4)); }
#pragma unroll
    for (int i = 0; i < 8; ++i) { const int kk = 8 * i + (lane >> 3); LAS float* s = scr + kk * 33 + (lane & 7) * 4; s[0] = v[i].x; s[1] = v[i].y; s[2] = v[i].z; s[3] = v[i].w; }
    LDS_WAIT(); asm volatile("" ::: "memory");
    const int c = lane & 7;
    float gk[8], bk[8];
    if constexpr (FOLD) {
#pragma unroll
        for (int j = 0; j < 8; ++j) { gk[j] = gvec[k0 + 8 * c + j]; bk[j] = bvec[k0 + 8 * c + j]; }
    }
#pragma unroll
    for (int j = 0; j < 4; ++j) { const int n = (lane >> 3) + 8 * j; const LAS float* s = scr + (8 * c) * 33 + n;
        float w[8];
#pragma unroll
        for (int q = 0; q < 8; ++q) w[q] = s[q * 33];
        v4u o;
        if constexpr (FOLD) {
            float cs = 0.f, us = 0.f; unsigned r[8];
#pragma unroll
            for (int q = 0; q < 8; ++q) { cs += bk[q] * w[q]; r[q] = f2bf(gk[q] * w[q]); us += __uint_as_float(r[q] << 16); }
            o.x = r[0] | (r[1] << 16); o.y = r[2] | (r[3] << 16); o.z = r[4] | (r[5] << 16); o.w = r[6] | (r[7] << 16);
            us += __shfl_xor(us, 1); cs += __shfl_xor(cs, 1); us += __shfl_xor(us, 2); cs += __shfl_xor(cs, 2); us += __shfl_xor(us, 4); cs += __shfl_xor(cs, 4);
            if (c == 0) { unsafeAtomicAdd(uvec + n0 + n, us); unsafeAtomicAdd(cvec + n0 + n, cs); }
        } else { o.x = pk2(w[0], w[1]); o.y = pk2(w[2], w[3]); o.z = pk2(w[4], w[5]); o.w = pk2(w[6], w[7]); }
        int nd = n0 + n; if (permute) nd = win_dest_row(nd);
        *(GAS v4u*)(WT + (size_t)nd * K + k0 + 8 * c) = o; }
    LDS_WAIT(); asm volatile("" ::: "memory");
}
struct P0Args { const float *x, *w_in, *w_out, *w1, *w2, *ln1_g, *ln1_b; bf16 *xb, *winT, *woT, *w1T, *w2T; float *rope, *dec, *uvec, *cvec; unsigned* queue; };
__device__ __forceinline__ void p0_prologue(Frame& F, const P0Args& A) {
    LAS float* scr = (LAS float*)(F.lds + RING_OFF + F.wave * 16384);
    volatile LAS unsigned* slot = F.MISC + 16;
    constexpr int I_IN = (DM / 64) * (NPROJ / 32), I_O = (DM / 64) * (DM / 32), I_1 = (DM / 64) * (DFF / 32), I_2 = (DFF / 64) * (DM / 32);
    constexpr int NT_ITEMS = I_IN + I_O + I_1 + I_2, NX_ITEMS = (int)((size_t)M * DM / 2048), NITEMS = NT_ITEMS + NX_ITEMS;
    static_assert(NITEMS % 8 == 0, "whole rounds");
    unsigned nxt = 0;
    if (F.tid == 0) nxt = __hip_atomic_fetch_add(A.queue, 8u, __ATOMIC_RELAXED, __HIP_MEMORY_SCOPE_AGENT);
    for (int rnd = 0;; ++rnd) {
        if (F.tid == 0) { slot[rnd & 1] = nxt; nxt = __hip_atomic_fetch_add(A.queue, 8u, __ATOMIC_RELAXED, __HIP_MEMORY_SCOPE_AGENT); }
        __syncthreads();
        const unsigned base = slot[rnd & 1];
        if (base >= (unsigned)NITEMS) break;
        int r = (int)base + F.wave;
        if (r < NT_ITEMS) {
            if (r < I_IN) p0_transpose_item<false>(A.w_in, DM, NPROJ, A.winT, scr, r, F.lane, true, nullptr, nullptr, nullptr, nullptr);
            else { r -= I_IN;
                if (r < I_O) p0_transpose_item<false>(A.w_out, DM, DM, A.woT, scr, r, F.lane, false, nullptr, nullptr, nullptr, nullptr);
                else { r -= I_O;
                    if (r < I_1) p0_transpose_item<true>(A.w1, DM, DFF, A.w1T, scr, r, F.lane, false, A.ln1_g, A.ln1_b, A.uvec, A.cvec);
                    else p0_transpose_item<false>(A.w2, DFF, DM, A.w2T, scr, r - I_1, F.lane, false, nullptr, nullptr, nullptr, nullptr); } }
        } else {
            const size_t i = (size_t)(r - NT_ITEMS) * 512 + F.lane; const GAS f32x4* xs = (const GAS f32x4*)A.x; GAS v2u* xd = (GAS v2u*)A.xb;
            f32x4 a[8];
#pragma unroll
            for (int j = 0; j < 8; ++j) a[j] = __builtin_nontemporal_load(xs + i + 64 * j);
#pragma unroll
            for (int j = 0; j < 8; ++j) { v2u o; o.x = pk2(a[j].x, a[j].y); o.y = pk2(a[j].z, a[j].w); xd[i + 64 * j] = o; }
        }
    }
    const int gw = F.vcu * NWAVES + F.wave, NGW = F.G * NWAVES;
    { const int gt = gw * 64 + F.lane, NT = NGW * 64;
      for (int e = gt; e < SEQ * 64; e += NT) { const int pos = e >> 6, i = e & 63;
          const float t = (float)i * (1.0f / 63.0f); const float inv = 1.0f / powf(10000.0f, t); const float ang = (float)pos * inv;
          A.rope[2 * e] = cosf(ang); A.rope[2 * e + 1] = sinf(ang); }
      for (int e = gt; e < 8 * 128; e += NT) { const int h = e >> 7, c = e & 127;
          const float lg = log1pf(-exp2f(-5.0f - (float)h));
          A.dec[2 * e] = expf((float)c * lg); A.dec[2 * e + 1] = expf(-(float)c * lg) * 0.08838834764831845f; } }
}

#define RET_TRRD(dst, base, off) asm volatile("ds_read_b64_tr_b16 %0, %1 offset:%2" : "=&v"(dst) : "v"(base), "i"(off) : "memory")
__device__ __forceinline__ float gamma_of(int h) { return 1.0f - exp2f(-5.0f - (float)h); }
__device__ __forceinline__ float pow_2k(float g, int k) { for (int i = 0; i < k; ++i) g = g * g; return g; }
__device__ __forceinline__ void ret_r1_chunk(Frame& F, const bf16* proj, bf16* sst, int u) {
    const int bh = u >> 6, n = u & 63, b = bh >> 3, h = bh & 7;
    int tid_ = F.tid; asm volatile("" : "+v"(tid_));
    const int tid = tid_, lane = tid & 63, wid = __builtin_amdgcn_readfirstlane(tid >> 6), r32 = lane & 31, hi = lane >> 5;
    const bf16* rowbase = proj + (size_t)(b * SEQ + n * 128) * NPROJ;
    unsigned char* lds = (unsigned char*)F.lds;
    {
        bf16x8 kv[4], vv[8];
#pragma unroll
        for (int j = 0; j < 4; ++j) { const int m = (tid >> 4) + 32 * j; kv[j] = *(const bf16x8*)(rowbase + (size_t)m * NPROJ + C_RK + h * 128 + (tid & 15) * 8); }
#pragma unroll
        for (int j = 0; j < 8; ++j) { const int m = (tid >> 5) + 16 * j; vv[j] = *(const bf16x8*)(rowbase + (size_t)m * NPROJ + C_RV + h * 256 + (tid & 31) * 8); }
#pragma unroll
        for (int j = 0; j < 4; ++j) { const int m = (tid >> 4) + 32 * j; *(bf16x8*)(lds + (m >> 6) * 16384 + att::v_st(m & 63, (tid & 15) * 8)) = kv[j]; }
#pragma unroll
        for (int j = 0; j < 8; ++j) { const int m = (tid >> 5) + 16 * j, e = (tid & 31) * 8; *(bf16x8*)(lds + 32768 + ((m >> 6) * 2 + (e >> 7)) * 16384 + att::v_st(m & 63, e & 127)) = vv[j]; }
    }
    __syncthreads();
    const int ib = wid & 3, eh = wid >> 2;
    f32x16 acc[4] = {};
    const int rb = att::v_rd_base(lane);
#pragma unroll
    for (int t = 0; t < 2; ++t) {
        const int kbase = (int)(uintptr_t)lds + t * 16384 + rb + ib * 512;
        const int vbase = (int)(uintptr_t)lds + 32768 + (t * 2 + eh) * 16384 + rb;
#pragma unroll
        for (int ks = 0; ks < 4; ++ks) {
            s16x4 al, ah, bl[4], bh_[4];
            RET_TRRD(al, kbase, ks * 4096); RET_TRRD(ah, kbase, ks * 4096 + 2048);
#pragma unroll
            for (int d0 = 0; d0 < 4; ++d0) { RET_TRRD(bl[d0], vbase, d0 * 512 + ks * 4096); RET_TRRD(bh_[d0], vbase, d0 * 512 + ks * 4096 + 2048); }
            asm volatile("s_waitcnt lgkmcnt(0)" ::: "memory"); __builtin_amdgcn_sched_barrier(0);
            const bf16x8 a = (bf16x8){al[0], al[1], al[2], al[3], ah[0], ah[1], ah[2], ah[3]};
#pragma unroll
            for (int d0 = 0; d0 < 4; ++d0) acc[d0] = __builtin_amdgcn_mfma_f32_32x32x16_bf16(a, (bf16x8){bl[d0][0], bl[d0][1], bl[d0][2], bl[d0][3], bh_[d0][0], bh_[d0][1], bh_[d0][2], bh_[d0][3]}, acc[d0], 0, 0, 0);
        }
    }
    const float g = gamma_of(h); float g127 = 1.f; { float p = g; for (int i = 0; i < 7; ++i) { g127 *= p; p = p * p; } }
    bf16* So = sst + ((size_t)(bh * 64 + n) * 128) * 256 + (size_t)(ib * 32 + 4 * hi) * 256 + eh * 128 + r32;
#pragma unroll
    for (int r = 0; r < 16; ++r) { const int dc = (r & 3) + 8 * (r >> 2);
#pragma unroll
        for (int d0 = 0; d0 < 4; ++d0) { const float y = acc[d0][r] * g127; const float yn = __shfl_xor(y, 1);
            if ((r32 & 1) == 0) *(unsigned*)(So + (size_t)dc * 256 + d0 * 32) = pk2(y, yn); } }
    __syncthreads();
}
__device__ __forceinline__ void ret_r2_scan(Frame& F, const bf16* sst, bf16* rg, unsigned* done_cnt) {
    const int nvec = 16 * 8192;
    for (int idx = F.vcu * 512 + F.tid; idx < nvec; idx += F.G * 512) {
        const int bh = idx >> 13, e4 = idx & 8191, h = bh & 7;
        const float g = gamma_of(h), gC = pow_2k(g, 7);
        const GAS v2u* sp = (const GAS v2u*)sst + (size_t)bh * 64 * 8192 + e4;
        unsigned long long* rp = (unsigned long long*)rg + (size_t)bh * 64 * 8192 + e4;
        f32x4 r = {0.f, 0.f, 0.f, 0.f};
        for (int n0 = 0; n0 < 64; n0 += 8) {
            v2u sv[8];
#pragma unroll
            for (int j = 0; j < 8; ++j) sv[j] = sp[(size_t)(n0 + j) * 8192];
#pragma unroll
            for (int j = 0; j < 8; ++j) { const f32x4 o = r * g; const unsigned long long w = (unsigned long long)pk2(o.x, o.y) | ((unsigned long long)pk2(o.z, o.w) << 32);
                __hip_atomic_store(rp + (size_t)(n0 + j) * 8192, w, __ATOMIC_RELAXED, __HIP_MEMORY_SCOPE_AGENT);
                const f32x4 sj = {__uint_as_float(sv[j].x << 16), __uint_as_float(sv[j].x & 0xffff0000u), __uint_as_float(sv[j].y << 16), __uint_as_float(sv[j].y & 0xffff0000u)};
                r = r * gC + sj; }
        }
    }
    VM_WAIT();
    if (F.lane == 0) __hip_atomic_fetch_add(done_cnt, 1u, __ATOMIC_RELAXED, __HIP_MEMORY_SCOPE_AGENT);
}
__device__ __forceinline__ void ret_r3_chunk(Frame& F, const bf16* proj, const bf16* rg, const float* gn_g, bf16* mix, int u) {
    const int bh = u >> 6, n = u & 63, b = bh >> 3, h = bh & 7;
    int tid_ = F.tid; asm volatile("" : "+v"(tid_));
    const int tid = tid_, lane = tid & 63, wid = __builtin_amdgcn_readfirstlane(tid >> 6), r32 = lane & 31, hi = lane >> 5;
    const size_t row0 = (size_t)(b * SEQ + n * 128);
    const bf16* rowbase = proj + row0 * NPROJ;
    const bf16* rgb = rg + (size_t)(bh * 64 + n) * 128 * 256;
    unsigned char* lds = (unsigned char*)F.lds;
    const int qb4 = wid & 3, eq = wid >> 2;
    bf16x8 qr[8];
#pragma unroll
    for (int d0 = 0; d0 < 8; ++d0) qr[d0] = *(const bf16x8*)(rowbase + (size_t)(qb4 * 32 + r32) * NPROJ + C_RQ + h * 128 + d0 * 16 + hi * 8);
#define R3_STAGE_K() do { bf16x8 kv[4]; _Pragma("unroll") for (int j = 0; j < 4; ++j) { const int m = (tid >> 4) + 32 * j; kv[j] = *(const bf16x8*)(rowbase + (size_t)m * NPROJ + C_RK + h * 128 + (tid & 15) * 8); } \
        _Pragma("unroll") for (int j = 0; j < 4; ++j) { const int m = (tid >> 4) + 32 * j; *(bf16x8*)(lds + (m >> 6) * 16384 + KSWZ(m & 63, (tid & 15) * 16)) = kv[j]; } } while (0)
#define R3_STAGE_VR(half) do { bf16x8 vv[4], rr[4]; _Pragma("unroll") for (int j = 0; j < 4; ++j) { const int m = (tid >> 4) + 32 * j; \
            vv[j] = *(const bf16x8*)(rowbase + (size_t)m * NPROJ + C_RV + h * 256 + (half) * 128 + (tid & 15) * 8); rr[j] = *(const bf16x8*)(rgb + (size_t)m * 256 + (half) * 128 + (tid & 15) * 8); } \
        _Pragma("unroll") for (int j = 0; j < 4; ++j) { const int m = (tid >> 4) + 32 * j; const int o_ = (m >> 6) * 16384 + att::v_st(m & 63, (tid & 15) * 8); *(bf16x8*)(lds + 32768 + o_) = vv[j]; *(bf16x8*)(lds + 65536 + o_) = rr[j]; } } while (0)
    R3_STAGE_K(); R3_STAGE_VR(0);
    __syncthreads();
    bf16x8 pa[8];
#pragma unroll
    for (int kt = 0; kt < 2; ++kt) {
        f32x16 p0 = {}, p1 = {};
        const unsigned char* kbp = lds + kt * 16384;
#pragma unroll
        for (int d0 = 0; d0 < 8; ++d0) { const unsigned char* a = kbp + KSWZ(r32, ((d0 & 3) * 16 + hi * 8) * 2) + (d0 >> 2) * 128;
            const bf16x8 b0 = *(const bf16x8*)a, b1 = *(const bf16x8*)(a + 32 * 256);
            p0 = __builtin_amdgcn_mfma_f32_32x32x16_bf16(b0, qr[d0], p0, 0, 0, 0);
            p1 = __builtin_amdgcn_mfma_f32_32x32x16_bf16(b1, qr[d0], p1, 0, 0, 0); }
        const int dq = qb4 * 32 + r32 - 64 * kt - 4 * hi;
#pragma unroll
        for (int r = 0; r < 16; ++r) { const int c = (r & 3) + 8 * (r >> 2); if (dq - c < 0) p0[r] = 0.f; if (dq - c - 32 < 0) p1[r] = 0.f; }
        ATT_PK4(p0, 0, pa[kt * 4 + 0]); ATT_PK4(p0, 8, pa[kt * 4 + 1]); ATT_PK4(p1, 0, pa[kt * 4 + 2]); ATT_PK4(p1, 8, pa[kt * 4 + 3]);
    }
    f32x16 o[2][2] = {};
    const int rb = (int)(uintptr_t)lds + att::v_rd_base(lane);
#define R3_ACC(half) do { _Pragma("unroll") for (int d0 = 0; d0 < 2; ++d0) { const int cb = (eq * 2 + d0) * 512; \
        _Pragma("unroll") for (int kt = 0; kt < 2; ++kt) { const int vb_ = rb + 32768 + kt * 16384 + cb, rb_ = rb + 65536 + kt * 16384 + cb; \
            _Pragma("unroll") for (int ks = 0; ks < 4; ++ks) { s16x4 vl, vh, rl, rh; \
                RET_TRRD(vl, vb_, ks * 4096); RET_TRRD(vh, vb_, ks * 4096 + 2048); RET_TRRD(rl, rb_, ks * 4096); RET_TRRD(rh, rb_, ks * 4096 + 2048); \
                asm volatile("s_waitcnt lgkmcnt(0)" ::: "memory"); __builtin_amdgcn_sched_barrier(0); \
                o[half][d0] = __builtin_amdgcn_mfma_f32_32x32x16_bf16(pa[kt * 4 + ks], (bf16x8){vl[0], vl[1], vl[2], vl[3], vh[0], vh[1], vh[2], vh[3]}, o[half][d0], 0, 0, 0); \
                o[half][d0] = __builtin_amdgcn_mfma_f32_32x32x16_bf16(qr[kt * 4 + ks], (bf16x8){rl[0], rl[1], rl[2], rl[3], rh[0], rh[1], rh[2], rh[3]}, o[half][d0], 0, 0, 0); } } } } while (0)
    R3_ACC(0);
    __syncthreads();
    R3_STAGE_VR(1);
    bf16x8 gq[8];
#pragma unroll
    for (int j = 0; j < 8; ++j) gq[j] = *(const bf16x8*)(rowbase + (size_t)((tid >> 5) + 16 * j) * NPROJ + C_RG + h * 256 + (tid & 31) * 8);
    __syncthreads();
    R3_ACC(1);
    LAS float* st = (LAS float*)(F.lds + 98304);
    LAS float* st_own = st + (wid * 32 + 4 * hi) * 2; LAS float* st_oth = st + ((wid ^ 4) * 32 + 4 * hi) * 2;
    {
        float s1[16], s2[16];
#pragma unroll
        for (int r = 0; r < 16; ++r) { const float a = o[0][0][r], b2 = o[0][1][r], c2 = o[1][0][r], d2 = o[1][1][r]; s1[r] = (a + b2) + (c2 + d2); s2[r] = (a * a + b2 * b2) + (c2 * c2 + d2 * d2); }
#pragma unroll
        for (int sft = 1; sft < 32; sft <<= 1)
#pragma unroll
            for (int r = 0; r < 16; ++r) { s1[r] += __shfl_xor(s1[r], sft); s2[r] += __shfl_xor(s2[r], sft); }
        if (r32 == 0) {
#pragma unroll
            for (int r = 0; r < 16; ++r) { const int c8 = ((r & 3) + 8 * (r >> 2)) * 2; st_own[c8] = s1[r]; st_own[c8 + 1] = s2[r]; }
        }
    }
    __syncthreads();
    constexpr int GST = 528;
#pragma unroll
    for (int j = 0; j < 8; ++j) *(bf16x8*)(lds + ((tid >> 5) + 16 * j) * GST + (tid & 31) * 16) = gq[j];
    __syncthreads();
    const float* gnp = gn_g + h * 256;
    const unsigned char* gl = lds + (qb4 * 32 + 4 * hi) * GST + (eq * 64 + r32) * 2;
    bf16* mp = mix + row0 * DM + 2048 + h * 256 + (size_t)(qb4 * 32 + 4 * hi) * DM + eq * 64 + r32;
    float gn[4];
#pragma unroll
    for (int q = 0; q < 4; ++q) gn[q] = gnp[(q >> 1) * 128 + eq * 64 + (q & 1) * 32 + r32];
#pragma unroll
    for (int r = 0; r < 16; ++r) { const int rc = (r & 3) + 8 * (r >> 2);
        const int c8 = ((r & 3) + 8 * (r >> 2)) * 2;
        const float t1 = st_own[c8] + st_oth[c8], t2 = st_own[c8 + 1] + st_oth[c8 + 1];
        const float mean = t1 * (1.0f / 256.0f), var = fmaxf(t2 * (1.0f / 256.0f) - mean * mean, 0.f), rstd = 1.0f / sqrtf(var + LN_EPS);
#pragma unroll
        for (int half = 0; half < 2; ++half)
#pragma unroll
            for (int d0 = 0; d0 < 2; ++d0) { const int e = half * 128 + d0 * 32;
                const float gate = bf2f(*(const unsigned short*)(gl + rc * GST + e * 2)); const float sg = gate / (1.0f + __expf(-gate));
                const float y = (o[half][d0][r] - mean) * rstd * gn[half * 2 + d0] * sg;
                const float yn = __shfl_xor(y, 1);
                if ((r32 & 1) == 0) *(unsigned*)(mp + (size_t)rc * DM + e) = pk2(y, yn); } }
    __syncthreads();
#undef R3_STAGE_K
#undef R3_STAGE_VR
#undef R3_ACC
}

__device__ __forceinline__ void ln2_apply(Frame& F, const bf16* pre2, const float* stats2, const float* gain, const float* bias, float* out) {
    const int gw = F.vcu * NWAVES + F.wave, NGW = F.G * NWAVES;
    f32x4 g[8][2], bb[8][2];
    { const GAS f32x4* gr = (const GAS f32x4*)gain + 2 * F.lane; const GAS f32x4* br = (const GAS f32x4*)bias + 2 * F.lane;
#pragma unroll
      for (int j = 0; j < 8; ++j) { g[j][0] = gr[128 * j]; g[j][1] = gr[128 * j + 1]; bb[j][0] = br[128 * j]; bb[j][1] = br[128 * j + 1]; } }
    for (int m = gw; m < M; m += NGW) {
        const float s1 = stats2[2 * m], s2 = stats2[2 * m + 1];
        const float mu = s1 * (1.f / DM), rs = 1.f / sqrtf(fmaxf(s2 * (1.f / DM) - mu * mu, 0.f) + LN_EPS);
        const GAS v4u* pr = (const GAS v4u*)(pre2 + (size_t)m * DM) + F.lane;
        v4u w[8];
#pragma unroll
        for (int j = 0; j < 8; ++j) w[j] = pr[64 * j];
        GAS f32x4* orow = (GAS f32x4*)(out + (size_t)m * DM) + 2 * F.lane;
#pragma unroll
        for (int j = 0; j < 8; ++j) {
            f32x4 p0, p1;
            p0[0] = __uint_as_float(w[j].x << 16); p0[1] = __uint_as_float(w[j].x & 0xffff0000u); p0[2] = __uint_as_float(w[j].y << 16); p0[3] = __uint_as_float(w[j].y & 0xffff0000u);
            p1[0] = __uint_as_float(w[j].z << 16); p1[1] = __uint_as_float(w[j].z & 0xffff0000u); p1[2] = __uint_as_float(w[j].w << 16); p1[3] = __uint_as_float(w[j].w & 0xffff0000u);
            orow[128 * j] = ((p0 - mu) * rs) * g[j][0] + bb[j][0]; orow[128 * j + 1] = ((p1 - mu) * rs) * g[j][1] + bb[j][1]; }
    }
}

struct Args { const float* in[13]; float* out; unsigned char* ws; int ph_lo, ph_hi; };
__global__ void __launch_bounds__(NWAVES * 64, 2) mega_fwd(Args args) {
    extern __shared__ __attribute__((aligned(16))) unsigned char lds[];
    Frame F;
    F.lds = (LAS unsigned char*)lds;
    F.MISC = (volatile LAS unsigned*)(F.lds + MISC_OFF);
    F.tid = threadIdx.x; F.lane = F.tid & 63; F.wave = __builtin_amdgcn_readfirstlane(F.tid >> 6);
    F.G = gridDim.x; { const int bx = blockIdx.x; F.vcu = (F.G % 8 == 0) ? (bx % 8) * (F.G / 8) + bx / 8 : bx; }
    unsigned char* ws = args.ws;
    F.ctl = (gu32*)(ws + WS_CTL);
    for (int u = F.tid; u < (LDS_BYTES - LDSCTL_OFF) / 4; u += NWAVES * 64) ((LAS unsigned*)(F.lds + LDSCTL_OFF))[u] = 0u;
    __syncthreads();
    XcdBarrier bar; bar.bar = (unsigned*)(F.ctl + CW_BAR); bar.x = 0; bar.st = nullptr;
    if (N_LAUNCHES == 1) bar = xcd_barrier_post((unsigned*)(F.ctl + CW_BAR), F.MISC + 8, F.tid == 0);
#define GRID_BAR() do { if (N_LAUNCHES == 1) { refresh_ids(F); xcd_barrier(bar, F.tid == 0); } } while (0)
    const int lo = args.ph_lo, hi = args.ph_hi;
#ifndef MK_PHMASK
#define MK_PHMASK 0x3ff
#endif
#define IN(k) (((MK_PHMASK >> (k)) & 1) && lo <= (k) && (k) < hi)
#define BOTH(k) (IN(k) && IN((k) + 1))
#ifndef MK_REPEAT
#define MK_REPEAT 0
#endif
#define REPS(k) (((MK_REPEAT >> (k)) & 1) ? 2 : 1)
    const float* x = args.in[0]; const float* w_in = args.in[1]; const float* att_lambda = args.in[2]; const float* att_subln_g = args.in[3]; const float* ret_gn_g = args.in[4];
    const float* w_out = args.in[5]; const float* ln1_g = args.in[6]; const float* ln1_b = args.in[7]; const float* w_ff1 = args.in[8]; const float* w_ff2 = args.in[9];
    const float* ln2_g = args.in[10]; const float* ln2_b = args.in[11]; const float* rel_bias = args.in[12];
    float* out = args.out;
    bf16* xb = (bf16*)(ws + WS_XB); bf16* mixb = (bf16*)(ws + WS_MIX); bf16* pre1b = (bf16*)(ws + WS_PRE1);
    float* stats2 = (float*)(ws + WS_STATS2); bf16* pre2b = (bf16*)(ws + WS_PRE2);
    float* stats = (float*)(ws + WS_STATS); float* uvec = (float*)(ws + WS_UVEC); float* cvec = (float*)(ws + WS_CVEC);
    bf16* winT = (bf16*)(ws + WS_WINT); bf16* woT = (bf16*)(ws + WS_WOT); bf16* w1T = (bf16*)(ws + WS_W1T); bf16* w2T = (bf16*)(ws + WS_W2T);
    bf16* proj = (bf16*)(ws + WS_PROJ); bf16* hb = (bf16*)(ws + WS_H);
    float* rope = (float*)(ws + WS_ROPE); float* dec = (float*)(ws + WS_DEC);
    bf16* sst = (bf16*)(ws + WS_SST); float* ascr = (float*)(ws + WS_ASCR); bf16* rgb = (bf16*)(ws + WS_RG);

    refresh_ids(F);
    if (IN(0)) { P0Args A{x, w_in, w_out, w_ff1, w_ff2, ln1_g, ln1_b, xb, winT, woT, w1T, w2T, rope, dec, uvec, cvec, (unsigned*)(ws + WS_QUEUE)}; _Pragma("unroll") for (int rep = 0; rep < REPS(0); ++rep) p0_prologue(F, A); if (BOTH(0)) GRID_BAR(); }

    refresh_ids(F);
    if (IN(1))
#pragma unroll
    for (int rep = 0; rep < REPS(1); ++rep) {
        pg8::Gemm g{xb, winT, M, NPROJ, DM}; pg8::StaticOrder S; S.init(M, NPROJ, F.G, (int)blockIdx.x);
        pg8::EpiProj E{proj, rope, dec};
        pg8::gemm_phase<pg8::EpiProj, pg8::StaticOrder, true, true>(F.lds + RING_OFF, g, S, E, F.wave);
        if (BOTH(1) && rep == REPS(1) - 1) GRID_BAR();
    }

    refresh_ids(F);
    if (IN(2)) { for (int uu = F.vcu; uu < 1024; uu += F.G) ret_r1_chunk(F, proj, sst, uu); if (BOTH(2)) GRID_BAR(); }

    refresh_ids(F);
    if (IN(3)) {
        unsigned* scan_cnt = (unsigned*)(ws + WS_QUEUE) + 64; unsigned* r3_head = (unsigned*)(ws + WS_QUEUE) + 128;
        ret_r2_scan(F, sst, rgb, scan_cnt);
        refresh_ids(F);
        float lam;
        { const float a = att_lambda[F.lane] * att_lambda[128 + F.lane] + att_lambda[64 + F.lane] * att_lambda[192 + F.lane];
          const float b2 = att_lambda[256 + F.lane] * att_lambda[384 + F.lane] + att_lambda[320 + F.lane] * att_lambda[448 + F.lane];
          lam = expf(wave_sum(a)) - expf(wave_sum(b2)) + LAMBDA_INIT; }
        char* alds = (char*)lds + RING_OFF; att::lds_ptr aldsa = (att::lds_ptr)(F.lds + RING_OFF);
        float* myscr = ascr + (size_t)blockIdx.x * (256 * 256);
        for (int uu = F.vcu; uu < 256; uu += F.G) {
            const int u = uu & 255, bh = u >> 4, xq = u & 15, b = bh >> 3, h = bh & 7;
            { float* T = (float*)(alds + att::OFF_BIAS); const float far = rel_bias[31 * 8 + h];
              refresh_ids(F);
              for (int i = F.tid; i < 384; i += NWAVES * 64) { const int dist = i - 128, nn = dist < 0 ? 0 : dist;
                  T[i] = nn >= 128 ? 0.f : (rel_bias[(int)T5_BUCKET[nn] * 8 + h] - far) * LOG2E; } }
            __syncthreads();
            const bf16* pb = proj + (size_t)b * SEQ * NPROJ;
            for (int i = 0; i < 4; ++i) {
                const int qb_ = i < 2 ? xq : 31 - xq, m_ = i & 1;
                att::BlockRef R;
                R.Q = pb + (size_t)qb_ * 256 * NPROJ + C_AQ + h * 256 + m_ * 128; R.K = pb + C_AK + h * 256 + m_ * 128; R.V = pb + C_AV + h * 256;
                R.O = myscr; R.mixrow = mixb + ((size_t)b * SEQ + qb_ * 256) * DM + h * 256; R.P0 = qb_ * 256; R.m = m_;
                att::block(R, aldsa, lam, att_subln_g, 1.0f - LAMBDA_INIT, F.wave);
            }
        }
        refresh_ids(F);
        if (F.wave == 0) {
            const unsigned want = (unsigned)F.G * NWAVES; unsigned sp_ = 0;
            while (__hip_atomic_load(scan_cnt, RLX_AGENT) < want) { __builtin_amdgcn_s_sleep(2); if (++sp_ > (1u << 22)) { if (F.lane == 0) atomicAdd((unsigned*)(F.ctl + CW_BAR) + XB_TMO, 1u); break; } }
            __builtin_amdgcn_fence(__ATOMIC_ACQUIRE, "agent");
            VM_WAIT();
        }
        __syncthreads();
        {
            volatile LAS unsigned* cslot = F.MISC + 20;
            unsigned nxt = 0;
            if (F.tid == 0) nxt = __hip_atomic_fetch_add(r3_head, 1u, __ATOMIC_RELAXED, __HIP_MEMORY_SCOPE_AGENT);
            for (int rnd = 0;; ++rnd) {
                refresh_ids(F);
                if (F.tid == 0) { cslot[rnd & 1] = nxt; nxt = __hip_atomic_fetch_add(r3_head, 1u, __ATOMIC_RELAXED, __HIP_MEMORY_SCOPE_AGENT); }
                __syncthreads();
                const unsigned uq = cslot[rnd & 1];
                if (uq >= 1024u) break;
                ret_r3_chunk(F, proj, rgb, ret_gn_g, mixb, (int)uq);
            }
        }
        if (BOTH(3)) GRID_BAR();
    }

    refresh_ids(F);
    if (IN(4))
#pragma unroll
    for (int rep = 0; rep < REPS(4); ++rep) {
        pg8::Gemm g{mixb, woT, M, DM, DM}; pg8::StaticOrder S; S.init(M, DM, F.G, (int)blockIdx.x);
        pg8::EpiPre1 E{x, pre1b, stats, DM, ALPHA};
        pg8::gemm_phase<pg8::EpiPre1, pg8::StaticOrder, true, true>(F.lds + RING_OFF, g, S, E, F.wave);
        if (BOTH(4) && rep == REPS(4) - 1) GRID_BAR();
    }

    refresh_ids(F);
    if (IN(5))
#pragma unroll
    for (int rep = 0; rep < REPS(5); ++rep) {
        pg8::Gemm g{pre1b, w1T, M, DFF, DM}; pg8::StaticOrder S; S.init(M, DFF, F.G, (int)blockIdx.x);
        pg8::EpiSqReluLn E{hb, DFF, stats, uvec, cvec, 1.0f / DM, LN_EPS};
        pg8::gemm_phase<pg8::EpiSqReluLn, pg8::StaticOrder, true, true>(F.lds + RING_OFF, g, S, E, F.wave);
        if (BOTH(5) && rep == REPS(5) - 1) GRID_BAR();
    }

    refresh_ids(F);
    if (IN(6))
#pragma unroll
    for (int rep = 0; rep < REPS(6); ++rep) {
        pg8::Gemm g{hb, w2T, M, DM, DFF}; pg8::StaticOrder S; S.init(M, DM, F.G, (int)blockIdx.x);
        pg8::EpiResidLn E{pre1b, pre2b, stats2, DM, stats, ln1_g, ln1_b, ALPHA, 1.0f / DM, LN_EPS};
        pg8::gemm_phase<pg8::EpiResidLn, pg8::StaticOrder, true, true>(F.lds + RING_OFF, g, S, E, F.wave);
        if (BOTH(6) && rep == REPS(6) - 1) GRID_BAR();
    }

    refresh_ids(F);
    if (IN(7)) {
        ln2_apply(F, pre2b, stats2, ln2_g, ln2_b, out);
        if (N_LAUNCHES == 1) { VM_WAIT(); __syncthreads();
            if (__hip_atomic_load((unsigned*)(F.ctl + CW_BAR) + XB_TMO, RLX_AGENT) != 0u) { const int gw = F.vcu * NWAVES + F.wave, NGW = F.G * NWAVES; const float q = __builtin_nanf("");
                for (int m = gw; m < M; m += NGW) { GAS f32x4* o = (GAS f32x4*)(out + (size_t)m * DM) + F.lane; for (int j = 0; j < 16; ++j) o[64 * j] = (f32x4){q, q, q, q}; } } }
    }
#undef IN
#undef BOTH
#undef GRID_BAR
}

extern "C" void kernel_launch(void* const* d_in, const int* in_sizes, int n_in, void* d_out, int out_size, void* d_ws, size_t ws_size, hipStream_t stream) {
    static int grid = 0;
    if (grid == 0) {
        if (n_in != 13 || in_sizes[0] != M * DM || out_size != M * DM || ws_size < WS_END) { fprintf(stderr, "kernel_launch: unexpected shapes (n_in %d, in0 %d, out %d, ws %zu); nothing launched\n", n_in, n_in > 0 ? in_sizes[0] : -1, out_size, ws_size); grid = -1; return; }
        int dev = 0, cus = 0, per_cu = 0;
        if (hipGetDevice(&dev) != hipSuccess || hipDeviceGetAttribute(&cus, hipDeviceAttributeMultiprocessorCount, dev) != hipSuccess) { fprintf(stderr, "kernel_launch: device query failed\n"); grid = -1; return; }
        if (hipFuncSetAttribute((const void*)mega_fwd, hipFuncAttributeMaxDynamicSharedMemorySize, LDS_BYTES) != hipSuccess) { fprintf(stderr, "kernel_launch: hipFuncSetAttribute failed\n"); grid = -1; return; }
        if (hipOccupancyMaxActiveBlocksPerMultiprocessor(&per_cu, (const void*)mega_fwd, NWAVES * 64, LDS_BYTES) != hipSuccess || per_cu < 1) fprintf(stderr, "kernel_launch: occupancy query reports %d\n", per_cu);
        (void)hipGetLastError();
        grid = cus;
    }
    if (grid < 0) return;
    if (hipMemsetAsync((char*)d_ws + WS_CTL, 0, CTL_ZERO_BYTES, stream) != hipSuccess) { fprintf(stderr, "kernel_launch: memset failed\n"); return; }
    Args a{};
    for (int i = 0; i < 13; ++i) a.in[i] = (const float*)d_in[i];
    a.out = (float*)d_out; a.ws = (unsigned char*)d_ws;
    for (int li = 0; li < N_LAUNCHES; ++li) {
        a.ph_lo = (N_LAUNCHES == 1) ? 0 : li; a.ph_hi = (N_LAUNCHES == 1) ? N_PHASES : li + 1;
        hipLaunchKernelGGL(mega_fwd, dim3(grid), dim3(NWAVES * 64), LDS_BYTES, stream, a);
        const hipError_t le = hipPeekAtLastError();
        if (le != hipSuccess) { fprintf(stderr, "kernel_launch: launch %d failed: %s\n", li, hipGetErrorName(le)); break; }
    }
}
```
